# Optimizing an MI355X kernel written in HIP

```python
import jax, jax.numpy as jnp
from jax import lax
import numpy as np

D_MODEL = 2048
BATCH = 4
SEQ = 2048
DEPTH = 4

CTX_LEN = 256
GRID_W = 64
Q_BLOCK = 128
ROPE_THETA = 10000.0
EPS = 1e-6

GQA_HEADS = 8
GQA_KV_HEADS = 2
GQA_GROUP = GQA_HEADS // GQA_KV_HEADS
GQA_HEAD_DIM = 128
GQA_WIDTH = GQA_HEADS * GQA_HEAD_DIM
MLA_HEADS = 8
MLA_NOPE_DIM = 128
MLA_ROPE_DIM = 64
MLA_QK_DIM = MLA_NOPE_DIM + MLA_ROPE_DIM
MLA_V_DIM = 128
MLA_Q_RANK = 512
MLA_KV_RANK = 512
MLA_WIDTH = MLA_HEADS * MLA_V_DIM
D_MIX = GQA_WIDTH + MLA_WIDTH
IN_SIZES = (GQA_WIDTH, GQA_KV_HEADS * GQA_HEAD_DIM, GQA_KV_HEADS * GQA_HEAD_DIM, GQA_WIDTH,
            MLA_Q_RANK, MLA_KV_RANK, MLA_ROPE_DIM, MLA_WIDTH)
D_IN = GQA_WIDTH + 2 * GQA_KV_HEADS * GQA_HEAD_DIM + GQA_WIDTH + MLA_Q_RANK + MLA_KV_RANK + MLA_ROPE_DIM + MLA_WIDTH

kernel_name = "hybrid_gqa_mla_prefix_dit"


def rms_norm(x, g):
    xf = x.astype(jnp.float32)
    y = xf * lax.rsqrt(jnp.mean(xf * xf, axis=-1, keepdims=True) + EPS)
    return (y * g.astype(jnp.float32)).astype(x.dtype)


def axial_rope_tables(n_tokens, rot_dim, dtype):
    rows = n_tokens // GRID_W
    row = jnp.repeat(jnp.arange(rows, dtype=jnp.float32), GRID_W)
    col = jnp.tile(jnp.arange(GRID_W, dtype=jnp.float32), rows)
    n_freq = rot_dim // 4
    inv = ROPE_THETA ** (-jnp.arange(n_freq, dtype=jnp.float32) / n_freq)
    ang = jnp.concatenate([row[:, None] * inv[None], col[:, None] * inv[None]], axis=-1)
    return jnp.cos(ang).astype(dtype), jnp.sin(ang).astype(dtype)


def apply_rope(x, tables):
    cos, sin = tables
    cos, sin = cos[None, :, None, :], sin[None, :, None, :]
    x1, x2 = jnp.split(x, 2, axis=-1)
    return jnp.concatenate([x1 * cos - x2 * sin, x2 * cos + x1 * sin], axis=-1)


def block_attention(q, k, v):
    B, Sq, Hk, G, Dk = q.shape
    nb = Sq // Q_BLOCK
    scale = Dk ** -0.5
    qb = q.reshape(B, nb, Q_BLOCK, Hk, G, Dk).swapaxes(0, 1)

    def one_block(qblk):
        s = jnp.einsum('bqhgd,bshd->bhgqs', qblk, k).astype(jnp.float32) * scale
        p = jax.nn.softmax(s, axis=-1).astype(v.dtype)
        return jnp.einsum('bhgqs,bshd->bqhgd', p, v)

    o = lax.map(one_block, qb)
    return o.swapaxes(0, 1).reshape(B, Sq, Hk * G * v.shape[-1])


def mixer_inputs(h, w_in, q_gain, k_gain, cq_gain, ckv_gain, w_uq, w_ukv, rope_gqa, rope_mla):
    B, S, _ = h.shape
    p = h @ w_in
    offsets = [int(o) for o in np.cumsum(IN_SIZES)[:-1]]
    q, k, v, g_gqa, cq, ckv, kr, g_mla = jnp.split(p, offsets, axis=-1)
    q = rms_norm(q.reshape(B, S, GQA_HEADS, GQA_HEAD_DIM), q_gain)
    k = rms_norm(k.reshape(B, S, GQA_KV_HEADS, GQA_HEAD_DIM), k_gain)
    v = v.reshape(B, S, GQA_KV_HEADS, GQA_HEAD_DIM)
    qm = (rms_norm(cq, cq_gain) @ w_uq).reshape(B, S, MLA_HEADS, MLA_QK_DIM)
    q_nope, q_rope = qm[..., :MLA_NOPE_DIM], qm[..., MLA_NOPE_DIM:]
    kvm = (rms_norm(ckv, ckv_gain) @ w_ukv).reshape(B, S, MLA_HEADS, MLA_NOPE_DIM + MLA_V_DIM)
    k_nope, v_mla = kvm[..., :MLA_NOPE_DIM], kvm[..., MLA_NOPE_DIM:]
    kr = kr.reshape(B, S, 1, MLA_ROPE_DIM)
    if rope_gqa is not None:
        q = apply_rope(q, rope_gqa)
        k = apply_rope(k, rope_gqa)
        q_rope = apply_rope(q_rope, rope_mla)
        kr = apply_rope(kr, rope_mla)
    q = q.reshape(B, S, GQA_KV_HEADS, GQA_GROUP, GQA_HEAD_DIM)
    q_mla = jnp.concatenate([q_nope, q_rope], axis=-1)[:, :, :, None, :]
    k_mla = jnp.concatenate([k_nope, jnp.broadcast_to(kr, (B, S, MLA_HEADS, MLA_ROPE_DIM))], axis=-1)
    return (q, k, v, g_gqa), (q_mla, k_mla, v_mla, g_mla)


def merge_groups(o_gqa, g_gqa, o_mla, g_mla, w_out):
    y = jnp.concatenate([o_gqa * jax.nn.silu(g_gqa), o_mla * jax.nn.silu(g_mla)], axis=-1)
    return y @ w_out


def setup_inputs(seed: int = 0) -> dict:
    key = jax.random.key(seed)
    ks = jax.random.split(key, 16)
    f = jnp.float32
    nrm = lambda k, shape, s: jax.random.normal(k, shape, f) * s
    return {
        "x": nrm(ks[0], (BATCH, SEQ, D_MODEL), 1.0),
        "c": nrm(ks[1], (BATCH, D_MODEL), 1.0),
        "ctx": nrm(ks[2], (BATCH, CTX_LEN, D_MODEL), 1.0),
        "c_ctx": nrm(ks[3], (D_MODEL,), 1.0),
        "w_ada": nrm(ks[4], (DEPTH, D_MODEL, 3 * D_MODEL), 0.5 * D_MODEL ** -0.5),
        "b_ada": nrm(ks[5], (DEPTH, 3 * D_MODEL), 0.01),
        "norm_g": 1.0 + nrm(ks[6], (DEPTH, D_MODEL), 0.02),
        "w_in": nrm(ks[7], (DEPTH, D_MODEL, D_IN), D_MODEL ** -0.5),
        "q_gain": 1.0 + nrm(ks[8], (DEPTH, GQA_HEAD_DIM), 0.02),
        "k_gain": 1.0 + nrm(ks[9], (DEPTH, GQA_HEAD_DIM), 0.02),
        "cq_gain": 1.0 + nrm(ks[10], (DEPTH, MLA_Q_RANK), 0.02),
        "ckv_gain": 1.0 + nrm(ks[11], (DEPTH, MLA_KV_RANK), 0.02),
        "w_uq": nrm(ks[12], (DEPTH, MLA_Q_RANK, MLA_HEADS * MLA_QK_DIM), MLA_Q_RANK ** -0.5),
        "w_ukv": nrm(ks[13], (DEPTH, MLA_KV_RANK, MLA_HEADS * (MLA_NOPE_DIM + MLA_V_DIM)), MLA_KV_RANK ** -0.5),
        "w_out": nrm(ks[14], (DEPTH, D_MIX, D_MODEL), D_MIX ** -0.5),
        "final_g": 1.0 + nrm(ks[15], (D_MODEL,), 0.02),
    }


def reference(x, c, ctx, c_ctx, w_ada, b_ada, norm_g, w_in, q_gain, k_gain, cq_gain, ckv_gain,
              w_uq, w_ukv, w_out, final_g):
    n_tok = x.shape[1]
    ROWS = n_tok // GRID_W
    rope_gqa = axial_rope_tables(ROWS * GRID_W, GQA_HEAD_DIM, x.dtype)
    rope_mla = axial_rope_tables(ROWS * GRID_W, MLA_ROPE_DIM, x.dtype)
    xc = ctx
    sc = jax.nn.silu(c)
    sc_ctx = jax.nn.silu(c_ctx)
    for l in range(DEPTH):
        shift, scale, gate = jnp.split(sc @ w_ada[l] + b_ada[l], 3, axis=-1)
        shift_c, scale_c, gate_c = jnp.split(sc_ctx @ w_ada[l] + b_ada[l], 3, axis=-1)
        h_lat = rms_norm(x, norm_g[l]) * (1.0 + scale[:, None]) + shift[:, None]
        h_ctx = rms_norm(xc, norm_g[l]) * (1.0 + scale_c) + shift_c
        lat_a, lat_b = mixer_inputs(h_lat, w_in[l], q_gain[l], k_gain[l], cq_gain[l], ckv_gain[l],
                                    w_uq[l], w_ukv[l], rope_gqa, rope_mla)
        ctx_a, ctx_b = mixer_inputs(h_ctx, w_in[l], q_gain[l], k_gain[l], cq_gain[l], ckv_gain[l],
                                    w_uq[l], w_ukv[l], None, None)
        o_a = block_attention(lat_a[0], jnp.concatenate([ctx_a[1], lat_a[1]], axis=1),
                              jnp.concatenate([ctx_a[2], lat_a[2]], axis=1))
        o_b = block_attention(lat_b[0], jnp.concatenate([ctx_b[1], lat_b[1]], axis=1),
                              jnp.concatenate([ctx_b[2], lat_b[2]], axis=1))
        x = x + gate[:, None] * merge_groups(o_a, lat_a[3], o_b, lat_b[3], w_out[l])
        if l < DEPTH - 1:
            oc_a = block_attention(ctx_a[0], ctx_a[1], ctx_a[2])
            oc_b = block_attention(ctx_b[0], ctx_b[1], ctx_b[2])
            xc = xc + gate_c * merge_groups(oc_a, ctx_a[3], oc_b, ctx_b[3], w_out[l])
    return rms_norm(x, final_g)
```

```cpp
#include <hip/hip_runtime.h>
#include <hip/hip_cooperative_groups.h>
#include <cstdio>
#include <cstdint>
namespace cg = cooperative_groups;

#ifndef MK_ONE_LAUNCH
#define MK_ONE_LAUNCH 1
#endif

constexpr int DM = 2048, NB = 4, SEQ = 2048, DEPTH = 4, CTXL = 256;
constexpr int NLAT = NB * SEQ, NCTX = NB * CTXL, MROWS = NLAT + NCTX;
constexpr int NKEY = CTXL + SEQ;
constexpr int D_IN = 4672, N1 = 4864;
constexpr int NMOD = 3 * DM;
constexpr float EPS = 1e-6f;
constexpr int NWAVES = 8, NTHREADS = 512;

#define GAS __attribute__((address_space(1)))
#define LAS __attribute__((address_space(3)))
typedef unsigned short bf16_t;
typedef short bf16x8 __attribute__((ext_vector_type(8)));
typedef short s16x4 __attribute__((ext_vector_type(4)));
typedef float f32x2 __attribute__((ext_vector_type(2)));
typedef float f32x4 __attribute__((ext_vector_type(4)));
typedef float f32x16 __attribute__((ext_vector_type(16)));
typedef unsigned u32x2 __attribute__((ext_vector_type(2)));
typedef unsigned u32x4 __attribute__((ext_vector_type(4)));

constexpr size_t al256(size_t x) { return (x + 255) / 256 * 256; }
constexpr size_t WS_CTL = 0, CTL_BYTES = 1u << 20;
constexpr size_t WS_MOD = WS_CTL + CTL_BYTES;
constexpr size_t WS_ROPEG = WS_MOD + al256((size_t)DEPTH * 5 * NMOD * 4);
constexpr size_t WS_ROPEM = WS_ROPEG + (size_t)SEQ * 64 * 8;
constexpr size_t WS_W1 = WS_ROPEM + (size_t)SEQ * 32 * 8;
constexpr size_t W1_L = (size_t)N1 * DM * 2;
constexpr size_t WS_W2A = WS_W1 + DEPTH * W1_L;
constexpr size_t W2A_L = (size_t)1536 * 512 * 2;
constexpr size_t WS_W2B = WS_W2A + DEPTH * W2A_L;
constexpr size_t W2B_L = (size_t)2048 * 512 * 2;
constexpr size_t WS_W3 = WS_W2B + DEPTH * W2B_L;
constexpr size_t W3_L = (size_t)DM * DM * 2;
constexpr size_t WS_H = WS_W3 + DEPTH * W3_L;
constexpr size_t WS_QG = WS_H + (size_t)MROWS * DM * 2;
constexpr size_t WS_QGF = WS_QG + (size_t)MROWS * 1024 * 2;
constexpr size_t WS_KG = WS_QGF + (size_t)MROWS * 1024 * 2;
constexpr size_t WS_KGF = WS_KG + (size_t)MROWS * 256 * 2;
constexpr size_t WS_VG = WS_KGF + (size_t)MROWS * 256 * 2;
constexpr size_t WS_GS = WS_VG + (size_t)MROWS * 256 * 2;
constexpr size_t WS_CQ = WS_GS + (size_t)MROWS * DM * 2;
constexpr size_t WS_CKV = WS_CQ + (size_t)MROWS * 512 * 2;
constexpr size_t WS_KR = WS_CKV + (size_t)MROWS * 512 * 2;
constexpr size_t WS_KRF = WS_KR + (size_t)MROWS * 64 * 2;
constexpr size_t WS_SSQ = WS_KRF + (size_t)MROWS * 64 * 2;
constexpr size_t WS_QMN = WS_SSQ + (size_t)MROWS * 16 * 4;
constexpr size_t WS_QMR = WS_QMN + (size_t)MROWS * 1024 * 2;
constexpr size_t WS_KMN = WS_QMR + (size_t)MROWS * 512 * 2;
constexpr size_t WS_VM = WS_KMN + (size_t)MROWS * 1024 * 2;
constexpr size_t WS_Y = WS_VM + (size_t)MROWS * 1024 * 2;
constexpr size_t WS_XC = WS_Y + (size_t)MROWS * DM * 2;
constexpr size_t WS_SLAB = WS_XC + (size_t)NCTX * DM * 4;
constexpr size_t WS_XH = WS_SLAB + (size_t)8 * NCTX * DM * 4;
constexpr size_t WS_XL = WS_XH + (size_t)NLAT * DM * 2;
constexpr size_t WS_SSQX = WS_XL + (size_t)NLAT * DM;
constexpr size_t WS_END = WS_SSQX + (size_t)NLAT * 8 * 4;

constexpr int CW_BAR = 4096;
constexpr size_t CTL_KMAX = 32768;
constexpr size_t CTL_KRMAX = 32768 + 4 * 4 * 8 * 4 * 2 * 16 * 4;

constexpr int RING_BYTES = 131072;
constexpr int LDSCTL_OFF = 163840 - 512, MISC_OFF = LDSCTL_OFF + 320;
constexpr int LDS_BYTES = 163840;

struct Params {
    const float *x, *c, *ctx, *c_ctx, *w_ada, *b_ada, *norm_g, *w_in, *q_gain, *k_gain, *cq_gain, *ckv_gain, *w_uq, *w_ukv, *w_out, *final_g;
    float* out; unsigned char* ws;
    int ph_lo, ph_hi;
};
typedef const __attribute__((address_space(4))) Params* KP;
__device__ __forceinline__ KP kparams() { KP p = (KP)__builtin_amdgcn_kernarg_segment_ptr(); asm volatile("" : "+s"(p)); return p; }

#define LDS_WAIT() asm volatile("s_waitcnt lgkmcnt(0)" ::: "memory")
#define VM_WAIT() asm volatile("s_waitcnt vmcnt(0)" ::: "memory")
#define SBAR() __builtin_amdgcn_sched_barrier(0)
__device__ __forceinline__ unsigned cvt_pk_bf16(float lo, float hi) { unsigned r; asm volatile("v_cvt_pk_bf16_f32 %0, %1, %2" : "=v"(r) : "v"(lo), "v"(hi)); return r; }
__device__ __forceinline__ float bf2f(unsigned short h) { return __uint_as_float((unsigned)h << 16); }
__device__ __forceinline__ float bflo(unsigned w) { return __uint_as_float(w << 16); }
__device__ __forceinline__ float bfhi(unsigned w) { return __uint_as_float(w & 0xffff0000u); }
__device__ __forceinline__ float silu_f(float v) { return v * __builtin_amdgcn_rcpf(1.0f + __builtin_amdgcn_exp2f(-1.4426950408889634f * v)); }
__device__ __forceinline__ float wave_sum(float v) {
#pragma unroll
    for (int o = 1; o < 64; o <<= 1) v += __shfl_xor(v, o);
    return v;
}
__device__ __forceinline__ int opaque_tid() { int t = threadIdx.x; asm volatile("" : "+v"(t)); return t; }
__device__ __forceinline__ int kvrow_of(int r) { if (r < NLAT) { const int b = r >> 11; return b * NKEY + CTXL + (r & 2047); } const int rr = r - NLAT; return (rr >> 8) * NKEY + (rr & 255); }

namespace pg8 {
constexpr int BM = 256, BK = 64, HALF = 128, HTB = HALF * BK * 2, STAGE_BYTES = 8 * HTB, NXCD = 8, WGM = 8;
__host__ __device__ __forceinline__ int lds_byte(int r, int c) { const int st = (r >> 4) * 2 + (c >> 5), rr = r & 15, cc = c & 31, ob = rr * 64 + cc * 2; return st * 1024 + (ob ^ (((ob >> 9) & 1) << 5)); }
__host__ __device__ __forceinline__ void stage_rc(int b, int& R, int& C) { const int st = b / 1024, sb = b % 1024, swz = sb ^ (((sb >> 9) & 1) << 5); R = (st >> 1) * 16 + swz / 64; C = (st & 1) * 32 + (swz % 64) / 2; }
__host__ __device__ __forceinline__ int perm32(int rho) { const int n = rho >> 4, i = rho & 15; return 8 * (i >> 2) + 4 * n + (i & 3); }

struct Unit { int pm, pn, g, k0, nt; };
struct Gemm { const bf16_t *A0, *A1, *B0, *B1; int K;
    __device__ __forceinline__ const char* a(int g) const { return (const char*)(g ? A1 : A0); }
    __device__ __forceinline__ const char* b(int g) const { return (const char*)(g ? B1 : B0); } };

struct StaticOrder {
    int nM, nN, nwg, G, c, nt;
    __device__ void init(int nM_, int nN_, int G_, int c_, int nt_) { nM = nM_; nN = nN_; nwg = nM * nN; G = G_; c = c_; nt = nt_; }
    __device__ bool next(int i, Unit& u) const {
        const long L = (long)i * G + c; if (L >= nwg) return false;
        int wgid = (int)L; { const int q = nwg / NXCD, r = nwg % NXCD, xcd = wgid % NXCD, off = wgid / NXCD; wgid = (xcd < r ? xcd * (q + 1) : r * (q + 1) + (xcd - r) * q) + off; }
        const int nig = WGM * nN, gid = wgid / nig, fm = gid * WGM, gsz = (nM - fm) < WGM ? (nM - fm) : WGM;
        u.pm = fm + ((wgid % nig) % gsz); u.pn = (wgid % nig) / gsz; u.g = 0; u.k0 = 0; u.nt = nt; return true;
    }
};
struct G3Order {
    int G, c, ctx;
    __device__ bool next(int i, Unit& u) const {
        int L = i * G + c;
        if (ctx && i < 2) L = (1 - i) * G + c;
        if (L < 256) { const int x = L & 7, j = L >> 3; u.pm = x * 4 + (j >> 3); u.pn = j & 7; u.g = 0; u.k0 = 0; u.nt = 32; return true; }
        if (!ctx || L >= 512) return false;
        const int r = L - 256, t = r >> 3; u.pm = 32 + (t >> 3); u.pn = t & 7; u.g = 1; u.k0 = (r & 7) * 256; u.nt = 4; return true;
    }
};
struct GroupOrder {
    int nM, nN0, nN1, G, c;
    __device__ bool next(int i, Unit& u) const {
        const int L = i * G + c; const int n0 = nM * nN0, n1 = nM * nN1; if (L >= n0 + n1) return false;
        if (L < n0) { u.g = 0; u.pm = L % nM; u.pn = L / nM; } else { const int r = L - n0; u.g = 1; u.pm = r % nM; u.pn = r / nM; }
        u.k0 = 0; u.nt = 8; return true;
    }
};

template <class Epi, class Sched, bool ALIGN_EPI, bool SP2>
__device__ __forceinline__ void gemm_phase(LAS unsigned char* lds, const Gemm g, const Sched& S, const Epi& E) {
    const int tid = opaque_tid(), wid = __builtin_amdgcn_readfirstlane(tid >> 6), lane = tid & 63, wr = wid >> 2, wc = wid & 3, fr = lane & 15, fq = lane >> 4;
    const int K = g.K;
    unsigned voffA[2], voffB[2];
#pragma unroll
    for (int i = 0; i < 2; ++i) { int R, C; stage_rc(tid * 16 + i * 8192, R, C); const int Rb = Epi::PERM ? ((R & ~31) + perm32(R & 31)) : R;
        voffA[i] = (unsigned)(R * K + C) * 2u; voffB[i] = (unsigned)(Rb * K + C) * 2u; }
    const size_t kstep = (size_t)(BK * 2);
    const size_t hstep = (size_t)HALF * K * 2;
    const size_t tstep = 2 * hstep;
    const unsigned ldsw = (unsigned)wid * 1024u;
    const int aoff = lds_byte(wr * 64 + fr, fq * 8), boff = lds_byte(wc * 32 + fr, fq * 8);
#define PG8_SA(b, h) (((b) * 2 + (h)) * HTB)
#define PG8_SB(b, h) ((4 + (b) * 2 + (h)) * HTB)
#define PG8_STAGE(bufoff, gbase, voff) do { _Pragma("unroll") for (int _i = 0; _i < 2; ++_i) \
        __builtin_amdgcn_global_load_lds((const unsigned*)((const char*)(gbase) + (voff)[_i]), (LAS unsigned*)(lds + (bufoff) + ldsw + _i * 8192), 16, 0, 0); } while (0)
#define PG8_LDA(dst, b, h) do { _Pragma("unroll") for (int m = 0; m < 4; ++m) _Pragma("unroll") for (int k = 0; k < 2; ++k) dst[m][k] = *(const LAS bf16x8*)(lds + PG8_SA(b, h) + aoff + m * 2048 + k * 1024); } while (0)
#define PG8_LDB(dst, b, h) do { _Pragma("unroll") for (int n = 0; n < 2; ++n) _Pragma("unroll") for (int k = 0; k < 2; ++k) dst[n][k] = *(const LAS bf16x8*)(lds + PG8_SB(b, h) + boff + n * 2048 + k * 1024); } while (0)
#define PG8_MMA(ai, bj, At, Bt) do { __builtin_amdgcn_s_setprio(1); _Pragma("unroll") for (int m = 0; m < 4; ++m) _Pragma("unroll") for (int n = 0; n < 2; ++n) _Pragma("unroll") for (int k = 0; k < 2; ++k) \
        acc[ai][bj][m][n] = __builtin_amdgcn_mfma_f32_16x16x32_bf16(Bt[n][k], At[m][k], acc[ai][bj][m][n], 0, 0, 0); __builtin_amdgcn_s_setprio(0); } while (0)
#define PG8_WAIT_V(n) asm volatile("s_waitcnt vmcnt(" #n ")" ::: "memory")
#define PG8_WAIT_L(n) asm volatile("s_waitcnt lgkmcnt(" #n ")" ::: "memory")
#define PG8_BAR __builtin_amdgcn_s_barrier()
#define PG8_SCHED __builtin_amdgcn_sched_barrier(0)
    Unit cur, nxt; int ui = 0;
    if (!S.next(0, cur)) return;
    f32x4 acc[2][2][4][2];
#pragma unroll
    for (int a = 0; a < 2; ++a)
#pragma unroll
        for (int b = 0; b < 2; ++b)
#pragma unroll
            for (int m = 0; m < 4; ++m)
#pragma unroll
                for (int n = 0; n < 2; ++n) acc[a][b][m][n] = (f32x4){0.f, 0.f, 0.f, 0.f};
    bf16x8 At[4][2], B0[2][2], B1[2][2];
    const char* cA = g.a(cur.g) + (size_t)cur.pm * tstep + (size_t)cur.k0 * 2; const char* cB = g.b(cur.g) + (size_t)cur.pn * tstep + (size_t)cur.k0 * 2;
    if constexpr (SP2) {
        PG8_STAGE(PG8_SB(0, 0), cB, voffB); PG8_STAGE(PG8_SB(0, 1), cB + hstep, voffB); PG8_STAGE(PG8_SA(0, 0), cA, voffA); PG8_STAGE(PG8_SA(0, 1), cA + hstep, voffA);
        if (wr == 1) PG8_BAR;
        PG8_WAIT_V(2); PG8_BAR;
        PG8_STAGE(PG8_SB(1, 0), cB + kstep, voffB); PG8_STAGE(PG8_SA(1, 0), cA + kstep, voffA); PG8_STAGE(PG8_SB(1, 1), cB + hstep + kstep, voffB);
        PG8_WAIT_V(6); PG8_BAR;
    } else {
        PG8_STAGE(PG8_SB(0, 0), cB, voffB); PG8_STAGE(PG8_SA(0, 0), cA, voffA); PG8_STAGE(PG8_SB(0, 1), cB + hstep, voffB); PG8_STAGE(PG8_SA(0, 1), cA + hstep, voffA);
        if (wr == 1) PG8_BAR;
        PG8_WAIT_V(4); PG8_BAR;
        PG8_STAGE(PG8_SB(1, 0), cB + kstep, voffB); PG8_STAGE(PG8_SA(1, 0), cA + kstep, voffA); PG8_STAGE(PG8_SB(1, 1), cB + hstep + kstep, voffB);
        PG8_WAIT_V(6); PG8_BAR;
    }
    for (;;) {
        const bool has_next = S.next(ui + 1, nxt);
        const char* nA = has_next ? g.a(nxt.g) + (size_t)nxt.pm * tstep + (size_t)nxt.k0 * 2 : cA; const char* nB = has_next ? g.b(nxt.g) + (size_t)nxt.pn * tstep + (size_t)nxt.k0 * 2 : cB;
        const int nt = cur.nt;
        for (int t = 0; t < nt; t += 2) {
            const bool last = (t == nt - 2);
            const char* a1 = cA + (size_t)(t + 1) * kstep;
            const char* a2 = last ? nA : cA + (size_t)(t + 2) * kstep; const char* b2 = last ? nB : cB + (size_t)(t + 2) * kstep;
            const char* a3 = a2 + kstep; const char* b3 = b2 + kstep;
            if constexpr (SP2) {
            PG8_LDB(B0, 0, 0); PG8_LDB(B1, 0, 1); PG8_SCHED; PG8_LDA(At, 0, 0); PG8_STAGE(PG8_SA(1, 1), a1 + hstep, voffA);
            PG8_WAIT_V(8); PG8_WAIT_L(0); PG8_BAR; PG8_MMA(0, 0, At, B0); PG8_MMA(0, 1, At, B1); PG8_BAR; PG8_SCHED;
            PG8_LDA(At, 0, 1); PG8_STAGE(PG8_SB(0, 0), b2, voffB); PG8_STAGE(PG8_SB(0, 1), b2 + hstep, voffB); PG8_STAGE(PG8_SA(0, 0), a2, voffA);
            PG8_WAIT_V(8); PG8_WAIT_L(0); PG8_BAR; PG8_MMA(1, 0, At, B0); PG8_MMA(1, 1, At, B1); PG8_BAR; PG8_SCHED;
            PG8_LDB(B0, 1, 0); PG8_LDB(B1, 1, 1); PG8_SCHED; PG8_LDA(At, 1, 0); PG8_STAGE(PG8_SA(0, 1), a2 + hstep, voffA);
            PG8_WAIT_V(8); PG8_WAIT_L(0); PG8_BAR; PG8_MMA(0, 0, At, B0); PG8_MMA(0, 1, At, B1); PG8_BAR; PG8_SCHED;
            PG8_LDA(At, 1, 1); PG8_STAGE(PG8_SB(1, 0), b3, voffB); PG8_STAGE(PG8_SB(1, 1), b3 + hstep, voffB); PG8_STAGE(PG8_SA(1, 0), a3, voffA);
            PG8_WAIT_V(8); PG8_WAIT_L(0); PG8_BAR; PG8_MMA(1, 0, At, B0); PG8_MMA(1, 1, At, B1); PG8_BAR; PG8_SCHED;
            } else {
            PG8_LDB(B0, 0, 0); PG8_SCHED; PG8_LDA(At, 0, 0); PG8_STAGE(PG8_SA(1, 1), a1 + hstep, voffA);
            PG8_WAIT_L(8); PG8_BAR; PG8_WAIT_L(0); PG8_MMA(0, 0, At, B0); PG8_BAR; PG8_SCHED;
            PG8_LDB(B1, 0, 1); PG8_STAGE(PG8_SB(0, 0), b2, voffB);
            PG8_BAR; PG8_WAIT_L(0); PG8_MMA(0, 1, At, B1); PG8_BAR;
            PG8_LDA(At, 0, 1); PG8_STAGE(PG8_SA(0, 0), a2, voffA);
            PG8_BAR; PG8_WAIT_L(0); PG8_MMA(1, 0, At, B0); PG8_BAR; PG8_SCHED;
            PG8_STAGE(PG8_SB(0, 1), b2 + hstep, voffB);
            PG8_WAIT_V(6); PG8_BAR; PG8_MMA(1, 1, At, B1); PG8_BAR;
            PG8_LDB(B0, 1, 0); PG8_SCHED; PG8_LDA(At, 1, 0); PG8_STAGE(PG8_SA(0, 1), a2 + hstep, voffA);
            PG8_WAIT_L(8); PG8_BAR; PG8_WAIT_L(0); PG8_MMA(0, 0, At, B0); PG8_BAR; PG8_SCHED;
            PG8_LDB(B1, 1, 1); PG8_STAGE(PG8_SB(1, 0), b3, voffB);
            PG8_BAR; PG8_WAIT_L(0); PG8_MMA(0, 1, At, B1); PG8_BAR;
            PG8_LDA(At, 1, 1); PG8_STAGE(PG8_SA(1, 0), a3, voffA);
            PG8_BAR; PG8_WAIT_L(0); PG8_MMA(1, 0, At, B0); PG8_BAR; PG8_SCHED;
            PG8_STAGE(PG8_SB(1, 1), b3 + hstep, voffB);
            PG8_WAIT_V(6); PG8_BAR; PG8_MMA(1, 1, At, B1); PG8_BAR;
            }
        }
        if constexpr (ALIGN_EPI) { if (wr == 0) PG8_BAR; }
        if constexpr (Epi::AFTER_DRAIN) { if (has_next) E(acc, cur, wr, wc, fr, fq); }
        else E(acc, cur, wr, wc, fr, fq);
        if (!has_next) break;
#pragma unroll
        for (int a = 0; a < 2; ++a)
#pragma unroll
            for (int b = 0; b < 2; ++b)
#pragma unroll
                for (int m = 0; m < 4; ++m)
#pragma unroll
                    for (int n = 0; n < 2; ++n) acc[a][b][m][n] = (f32x4){0.f, 0.f, 0.f, 0.f};
        cur = nxt; cA = nA; cB = nB; ++ui;
        if constexpr (ALIGN_EPI) { if (wr == 1) PG8_BAR; }
    }
    PG8_WAIT_V(0);
    if constexpr (!ALIGN_EPI) { if (wr == 0) PG8_BAR; }
    PG8_BAR;
    if constexpr (Epi::AFTER_DRAIN) E.fused(acc, cur, wr, wc, fr, fq);
#undef PG8_SA
#undef PG8_SB
#undef PG8_STAGE
#undef PG8_LDA
#undef PG8_LDB
#undef PG8_MMA
#undef PG8_WAIT_V
#undef PG8_WAIT_L
#undef PG8_BAR
#undef PG8_SCHED
}
}

#define XB_TMO      128
#define XB_XCNT(j)  (256  + 64 * (j))
#define XB_XSUB(j)  (1280 + 64 * (j))
#define XB_XGEN(j)  (2304 + 64 * (j))
#define XB_TOP      3328
#define XB_TOPGEN   3392
#define XCD_BAR_WORDS 3456
#define XB_SPIN_CAP (1u << 18)
__device__ __forceinline__ unsigned xb_ld(unsigned* p)              { return __hip_atomic_load(p, __ATOMIC_RELAXED, __HIP_MEMORY_SCOPE_AGENT); }
__device__ __forceinline__ unsigned xb_add(unsigned* p, unsigned v) { return __hip_atomic_fetch_add(p, v, __ATOMIC_RELAXED, __HIP_MEMORY_SCOPE_AGENT); }
__device__ __forceinline__ unsigned xb_xcc_id() { return (unsigned)__builtin_amdgcn_s_getreg((3 << 11) | 20) & 0xFu; }
#define XB_SPIN(cond, bar) do { unsigned _sp = 0; while (cond) { __builtin_amdgcn_s_sleep(1); \
    if ((++_sp & 255u) == 0u) { if (xb_ld(&(bar)[XB_TMO])) break; if (_sp > XB_SPIN_CAP) { atomicAdd(&(bar)[XB_TMO], 1u); break; } } } } while (0)
struct XcdBarrier { unsigned* bar; unsigned x; volatile LAS unsigned* st; };
__device__ __forceinline__ XcdBarrier xcd_barrier_post(unsigned* bar, volatile LAS unsigned* st) {
    XcdBarrier b; b.bar = bar; b.x = xb_xcc_id(); b.st = st;
    if (threadIdx.x == 0) (void)xb_add(&bar[XB_XCNT(b.x)], 1u);
    return b;
}
__device__ __forceinline__ void xcd_barrier_complete(unsigned* bar, unsigned x, unsigned& nloc, unsigned& nx) {
    const unsigned G = gridDim.x * gridDim.y * gridDim.z;
    unsigned sum, cnt, mine, sp = 0u;
    for (;;) {
        sum = 0u; cnt = 0u; mine = 0u;
#pragma unroll
        for (unsigned j = 0; j < 16; ++j) { const unsigned c = xb_ld(&bar[XB_XCNT(j)]); sum += c; cnt += (c > 0u) ? 1u : 0u; mine = (j == x) ? c : mine; }
        if (sum == G) break;
        __builtin_amdgcn_s_sleep(1);
        if ((++sp & 255u) == 0u) { if (xb_ld(&bar[XB_TMO])) break; if (sp > XB_SPIN_CAP) { atomicAdd(&bar[XB_TMO], 1u); break; } }
    }
    nloc = mine > 0u ? mine : 1u; nx = cnt > 0u ? cnt : 1u;
}
__device__ __forceinline__ void xcd_barrier(const XcdBarrier& b) {
    asm volatile("s_waitcnt vmcnt(0)" ::: "memory");
    __syncthreads();
    if (threadIdx.x == 0) {
        unsigned* bar = b.bar;
        __builtin_amdgcn_s_waitcnt(0);
        unsigned nloc = b.st[0], nx = b.st[1];
        if (nloc == 0u) { xcd_barrier_complete(bar, b.x, nloc, nx); b.st[0] = nloc; b.st[1] = nx; }
        const unsigned old = xb_add(&bar[XB_XSUB(b.x)], 1u);
        const unsigned gen = old / nloc;
        if (old + 1u == (gen + 1u) * nloc) {
            __builtin_amdgcn_fence(__ATOMIC_RELEASE, "agent");
            asm volatile("s_waitcnt vmcnt(0)" ::: "memory");
            const unsigned og = xb_add(&bar[XB_TOP], 1u);
            const unsigned tg = og / nx;
            if (og + 1u == (tg + 1u) * nx) xb_add(&bar[XB_TOPGEN], 1u);
            else XB_SPIN(xb_ld(&bar[XB_TOPGEN]) == tg, bar);
            __builtin_amdgcn_fence(__ATOMIC_ACQUIRE, "agent");
            xb_add(&bar[XB_XGEN(b.x)], 1u);
            asm volatile("s_waitcnt vmcnt(0)" ::: "memory");
        } else {
            XB_SPIN(xb_ld(&bar[XB_XGEN(b.x)]) == gen, bar);
            __builtin_amdgcn_fence(__ATOMIC_ACQUIRE, "agent");
            asm volatile("s_waitcnt vmcnt(0)" ::: "memory");
        }
    }
    __syncthreads();
}

__device__ __forceinline__ u32x4 pack8(f32x4 a, f32x4 b) { u32x4 w; w.x = cvt_pk_bf16(a[0], a[1]); w.y = cvt_pk_bf16(a[2], a[3]); w.z = cvt_pk_bf16(b[0], b[1]); w.w = cvt_pk_bf16(b[2], b[3]); return w; }

__device__ __forceinline__ void xenc8(const f32x4 a, const f32x4 b, u32x4& hi, u32x2& lo) {
    hi.x = cvt_pk_bf16(a[0], a[1]); hi.y = cvt_pk_bf16(a[2], a[3]); hi.z = cvt_pk_bf16(b[0], b[1]); hi.w = cvt_pk_bf16(b[2], b[3]);
    int w0 = __builtin_amdgcn_cvt_pk_fp8_f32((a[0] - bflo(hi.x)) * 256.f, (a[1] - bfhi(hi.x)) * 256.f, 0, false);
    w0 = __builtin_amdgcn_cvt_pk_fp8_f32((a[2] - bflo(hi.y)) * 256.f, (a[3] - bfhi(hi.y)) * 256.f, w0, true);
    int w1 = __builtin_amdgcn_cvt_pk_fp8_f32((b[0] - bflo(hi.z)) * 256.f, (b[1] - bfhi(hi.z)) * 256.f, 0, false);
    w1 = __builtin_amdgcn_cvt_pk_fp8_f32((b[2] - bflo(hi.w)) * 256.f, (b[3] - bfhi(hi.w)) * 256.f, w1, true);
    lo.x = (unsigned)w0; lo.y = (unsigned)w1;
}
__device__ __forceinline__ void xdec8(const u32x4 hi, const u32x2 lo, f32x4& a, f32x4& b) {
    const f32x2 d0 = __builtin_amdgcn_cvt_pk_f32_fp8((int)lo.x, false), d1 = __builtin_amdgcn_cvt_pk_f32_fp8((int)lo.x, true);
    const f32x2 d2 = __builtin_amdgcn_cvt_pk_f32_fp8((int)lo.y, false), d3 = __builtin_amdgcn_cvt_pk_f32_fp8((int)lo.y, true);
    constexpr float S = 1.0f / 256.f;
    a[0] = fmaf(d0.x, S, bflo(hi.x)); a[1] = fmaf(d0.y, S, bfhi(hi.x)); a[2] = fmaf(d1.x, S, bflo(hi.y)); a[3] = fmaf(d1.y, S, bfhi(hi.y));
    b[0] = fmaf(d2.x, S, bflo(hi.z)); b[1] = fmaf(d2.y, S, bfhi(hi.z)); b[2] = fmaf(d3.x, S, bflo(hi.w)); b[3] = fmaf(d3.y, S, bfhi(hi.w));
}

struct Epi1 {
    static constexpr bool PERM = true, AFTER_DRAIN = false;
    unsigned char* ws;
    __device__ __forceinline__ void operator()(f32x4 (&acc)[2][2][4][2], const pg8::Unit& u, int wr, int wc, int fr, int fq) const {
        const int pn = u.pn, pm = u.pm;
        const int row0 = pm * 256 + wr * 64 + fr;
        const int lc = wc * 32 + 8 * fq;
        bf16_t* base; int ld, coff; int mode = 0, ssq0 = 0; int rdelta = 0;
        float* SSQ = (float*)(ws + WS_SSQ);
        if (pn < 4) { base = (bf16_t*)(ws + WS_QG); ld = 1024; coff = 256 * pn; }
        else if (pn == 4) { base = (bf16_t*)(ws + WS_KG); ld = 256; coff = 0; }
        else if (pn == 5) { base = (bf16_t*)(ws + WS_VG); ld = 256; coff = 0; rdelta = (pm < 32) ? ((pm >> 3) * 256 + 256) : ((pm - 32) * 2048 - NLAT); }
        else if (pn < 10) { base = (bf16_t*)(ws + WS_GS); ld = 2048; coff = 256 * (pn - 6); mode = 1; }
        else if (pn < 12) { base = (bf16_t*)(ws + WS_CQ); ld = 512; coff = 256 * (pn - 10); mode = 2; ssq0 = (pn - 10) * 4; }
        else if (pn < 14) { base = (bf16_t*)(ws + WS_CKV); ld = 512; coff = 256 * (pn - 12); mode = 2; ssq0 = 8 + (pn - 12) * 4; }
        else if (pn < 18) { base = (bf16_t*)(ws + WS_GS); ld = 2048; coff = 1024 + 256 * (pn - 14); mode = 1; }
        else { base = (bf16_t*)(ws + WS_KR); ld = 64; coff = 0; mode = 3; }
#pragma unroll
        for (int ai = 0; ai < 2; ++ai)
#pragma unroll
            for (int m = 0; m < 4; ++m) {
                const int r = row0 + ai * 128 + m * 16;
                bf16_t* rowp = base + (size_t)(r + rdelta) * ld + coff + lc;
                if (mode == 1) {
#pragma unroll
                    for (int bj = 0; bj < 2; ++bj) { f32x4 v0 = acc[ai][bj][m][0], v1 = acc[ai][bj][m][1];
#pragma unroll
                        for (int j = 0; j < 4; ++j) { v0[j] = silu_f(v0[j]); v1[j] = silu_f(v1[j]); }
                        *(u32x4*)(rowp + bj * 128) = pack8(v0, v1); }
                } else if (mode == 3) {
                    if (wc < 2) *(u32x4*)(rowp) = pack8(acc[ai][0][m][0], acc[ai][0][m][1]);
                } else {
                    float s = 0.f;
#pragma unroll
                    for (int bj = 0; bj < 2; ++bj) { const f32x4 v0 = acc[ai][bj][m][0], v1 = acc[ai][bj][m][1];
                        if (mode == 2) s += (v0[0] * v0[0] + v0[1] * v0[1]) + (v0[2] * v0[2] + v0[3] * v0[3]) + (v1[0] * v1[0] + v1[1] * v1[1]) + (v1[2] * v1[2] + v1[3] * v1[3]);
                        *(u32x4*)(rowp + bj * 128) = pack8(v0, v1); }
                    if (mode == 2) { s += __shfl_xor(s, 16); s += __shfl_xor(s, 32); if (fq == 0) SSQ[(size_t)r * 16 + ssq0 + wc] = s; }
                }
            }
    }
};

struct Epi2 {
    static constexpr bool PERM = true, AFTER_DRAIN = false;
    unsigned char* ws; int l;
    __device__ __forceinline__ void operator()(f32x4 (&acc)[2][2][4][2], const pg8::Unit& u, int wr, int wc, int fr, int fq) const {
        const int pn = u.pn, pm = u.pm, g = u.g;
        const int row0 = pm * 256 + wr * 64 + fr;
        const int lc = wc * 32 + 8 * fq;
        const int rdelta = (pm < 32) ? ((pm >> 3) * 256 + 256) : ((pm - 32) * 2048 - NLAT);
        bf16_t* QMN = (bf16_t*)(ws + WS_QMN); bf16_t* QMR = (bf16_t*)(ws + WS_QMR); bf16_t* KMN = (bf16_t*)(ws + WS_KMN); bf16_t* VM = (bf16_t*)(ws + WS_VM);
        const float* SSQ = (const float*)(ws + WS_SSQ); const f32x2* ropeM = (const f32x2*)(ws + WS_ROPEM);
        float kmx = 0.f;
#pragma unroll
        for (int ai = 0; ai < 2; ++ai)
#pragma unroll
            for (int m = 0; m < 4; ++m) {
                const int r = row0 + ai * 128 + m * 16;
                const f32x4* sp = (const f32x4*)(SSQ + (size_t)r * 16 + g * 8);
                const f32x4 s0 = sp[0], s1 = sp[1];
                const float ss = ((s0[0] + s0[1]) + (s0[2] + s0[3])) + ((s1[0] + s1[1]) + (s1[2] + s1[3]));
                const float rs = __builtin_amdgcn_rsqf(ss * (1.0f / 512.0f) + EPS) * (g == 0 ? 0.07216878364870323f * 1.4426950408889634f : 1.0f);
                f32x4 a0 = acc[ai][0][m][0] * rs, a1 = acc[ai][0][m][1] * rs, b0 = acc[ai][1][m][0] * rs, b1 = acc[ai][1][m][1] * rs;
                if (g == 0) {
                    if (pn < 4) {
                        bf16_t* rowp = QMN + (size_t)r * 1024 + 256 * pn + lc;
                        *(u32x4*)(rowp) = pack8(a0, a1); *(u32x4*)(rowp + 128) = pack8(b0, b1);
                    } else {
                        const int head = 4 * (pn - 4) + wc, i0 = 8 * fq;
                        if (pm < 32) {
                            const f32x2* cs = ropeM + (size_t)(r & 2047) * 32 + i0;
#pragma unroll
                            for (int j = 0; j < 4; ++j) { const f32x2 t0 = cs[j], t1 = cs[4 + j];
                                const float x1 = a0[j], x2 = b0[j]; a0[j] = x1 * t0.x - x2 * t0.y; b0[j] = x2 * t0.x + x1 * t0.y;
                                const float y1 = a1[j], y2 = b1[j]; a1[j] = y1 * t1.x - y2 * t1.y; b1[j] = y2 * t1.x + y1 * t1.y; }
                        }
                        bf16_t* rowp = QMR + (size_t)r * 512 + head * 64 + i0;
                        *(u32x4*)(rowp) = pack8(a0, a1); *(u32x4*)(rowp + 32) = pack8(b0, b1);
                    }
                } else {
                    const size_t o = (size_t)(r + rdelta) * 1024 + pn * 128 + lc;
                    *(u32x4*)(KMN + o) = pack8(a0, a1); *(u32x4*)(VM + o) = pack8(b0, b1);
                    float s = ((a0[0] * a0[0] + a0[1] * a0[1]) + (a0[2] * a0[2] + a0[3] * a0[3])) + ((a1[0] * a1[0] + a1[1] * a1[1]) + (a1[2] * a1[2] + a1[3] * a1[3]));
                    s += __shfl_xor(s, 16); s += __shfl_xor(s, 32); kmx = fmaxf(kmx, s);
                }
                asm volatile("" ::: "memory");
            }
        if (g == 1) {
            kmx = fmaxf(kmx, __shfl_xor(kmx, 1)); kmx = fmaxf(kmx, __shfl_xor(kmx, 2)); kmx = fmaxf(kmx, __shfl_xor(kmx, 4)); kmx = fmaxf(kmx, __shfl_xor(kmx, 8));
            const int b = pm < 32 ? (pm >> 3) : (pm - 32);
            if ((fr | fq) == 0) ((float*)(ws + WS_CTL + CTL_KMAX))[((((l * 4 + b) * 8 + pn) * 4 + wc) * 2 + wr) * 16 + (pm < 32 ? (pm & 7) : 8)] = kmx;
        }
    }
};

struct Epi3 {
    static constexpr bool PERM = true, AFTER_DRAIN = true;
    unsigned char* ws; LAS unsigned char* lds; int l;
    __device__ __forceinline__ void operator()(f32x4 (&acc)[2][2][4][2], const pg8::Unit& u, int wr, int wc, int fr, int fq) const {
        const int pm = u.pm;
        const int col0 = u.pn * 256 + wc * 32 + 8 * fq;
        if (u.g == 1) {
            bf16_t* sl = (bf16_t*)(ws + WS_SLAB) + (size_t)(u.k0 >> 8) * NCTX * DM;
            const int row0 = (pm - 32) * 256 + wr * 64 + fr;
#pragma unroll
            for (int ai = 0; ai < 2; ++ai)
#pragma unroll
                for (int m = 0; m < 4; ++m) { const size_t off = (size_t)(row0 + ai * 128 + m * 16) * DM + col0;
#pragma unroll
                    for (int bj = 0; bj < 2; ++bj) *(u32x4*)(sl + off + bj * 128) = pack8(acc[ai][bj][m][0], acc[ai][bj][m][1]); }
        }
    }
    __device__ __forceinline__ void fused(f32x4 (&acc)[2][2][4][2], const pg8::Unit& u, int wr, int wc, int fr, int fq) const {
        const int pm = u.pm;
        const int col0 = u.pn * 256 + wc * 32 + 8 * fq;
        const int b5 = pm >> 3;
        const int row0 = pm * 256 + wr * 64 + fr;
        const KP P = kparams();
        const bool first = l == 0, last = l == DEPTH - 1;
        const float* x0 = P->x; bf16_t* XH = (bf16_t*)(ws + WS_XH); unsigned char* XL = ws + WS_XL; bf16_t* H = (bf16_t*)(ws + WS_H); float* outp = P->out; float* ssqx = (float*)(ws + WS_SSQX);
        const float* mod = (const float*)(ws + WS_MOD) + (size_t)l * 5 * NMOD; const float* modn = mod + (last ? 0 : 5 * NMOD);
        const float* gn = last ? P->final_g : P->norm_g + (l + 1) * DM;
        XcdBarrier bar; bar.bar = (unsigned*)(ws + WS_CTL) + CW_BAR; bar.x = xb_xcc_id(); bar.st = (volatile LAS unsigned*)(lds + MISC_OFF) + 8;
        LAS float* Pl = (LAS float*)(lds + RING_BYTES);
        {
            const float* gp = mod + b5 * NMOD + 2 * DM + col0;
#pragma unroll
            for (int ai = 0; ai < 2; ++ai)
#pragma unroll
                for (int m = 0; m < 4; ++m) { const size_t off = (size_t)(row0 + ai * 128 + m * 16) * DM + col0; float s = 0.f;
#pragma unroll
                    for (int bj = 0; bj < 2; ++bj) { f32x4 xa, xb;
                        if (first) { xa = *(const f32x4*)(x0 + off + bj * 128); xb = *(const f32x4*)(x0 + off + bj * 128 + 4); }
                        else xdec8(*(const u32x4*)(XH + off + bj * 128), *(const u32x2*)(XL + off + bj * 128), xa, xb);
                        const f32x4 na = xa + *(const f32x4*)(gp + bj * 128) * acc[ai][bj][m][0], nb = xb + *(const f32x4*)(gp + bj * 128 + 4) * acc[ai][bj][m][1];
                        acc[ai][bj][m][0] = na; acc[ai][bj][m][1] = nb;
                        s += ((na[0] * na[0] + na[1] * na[1]) + (na[2] * na[2] + na[3] * na[3])) + ((nb[0] * nb[0] + nb[1] * nb[1]) + (nb[2] * nb[2] + nb[3] * nb[3])); }
                    asm volatile("" : "+v"(acc[ai][0][m][0]), "+v"(acc[ai][0][m][1]), "+v"(acc[ai][1][m][0]), "+v"(acc[ai][1][m][1]));
                    s += __shfl_xor(s, 16); s += __shfl_xor(s, 32);
                    Pl[fq == 0 ? (ai * 128 + wr * 64 + m * 16 + fr) * 4 + wc : 1024 + wc * 64 + fq * 16 + fr] = s;
                    asm volatile("" ::: "memory"); }
            asm volatile("s_waitcnt lgkmcnt(0)" ::: "memory"); __builtin_amdgcn_s_barrier(); asm volatile("" ::: "memory");
            const int tid = opaque_tid();
            if (tid < 256) { const LAS f32x4* p4 = (const LAS f32x4*)Pl + tid; const f32x4 q = *p4; ssqx[(size_t)(pm * 256 + tid) * 8 + u.pn] = (q[0] + q[1]) + (q[2] + q[3]); }
        }
        xcd_barrier(bar);
        {
            float rs[2][4];
#pragma unroll
            for (int ai = 0; ai < 2; ++ai)
#pragma unroll
                for (int m = 0; m < 4; ++m) { const int r = row0 + ai * 128 + m * 16;
                    const f32x4 s0 = *(const f32x4*)(ssqx + (size_t)r * 8), s1 = *(const f32x4*)(ssqx + (size_t)r * 8 + 4);
                    rs[ai][m] = rsqrtf((((s0[0] + s0[1]) + (s0[2] + s0[3])) + ((s1[0] + s1[1]) + (s1[2] + s1[3]))) * (1.0f / DM) + EPS); }
            if (last) {
#pragma unroll
                for (int bj = 0; bj < 2; ++bj) { const int c = col0 + bj * 128; const f32x4 ga = *(const f32x4*)(gn + c), gb = *(const f32x4*)(gn + c + 4);
#pragma unroll
                    for (int ai = 0; ai < 2; ++ai)
#pragma unroll
                        for (int m = 0; m < 4; ++m) { float* op = outp + (size_t)(row0 + ai * 128 + m * 16) * DM + c;
                            *(f32x4*)(op) = acc[ai][bj][m][0] * rs[ai][m] * ga; *(f32x4*)(op + 4) = acc[ai][bj][m][1] * rs[ai][m] * gb; }
                    asm volatile("" ::: "memory"); }
            } else {
#pragma unroll
                for (int bj = 0; bj < 2; ++bj) { const int c = col0 + bj * 128;
                    const f32x4 ga = *(const f32x4*)(gn + c) * (*(const f32x4*)(modn + b5 * NMOD + DM + c) + 1.0f), gb = *(const f32x4*)(gn + c + 4) * (*(const f32x4*)(modn + b5 * NMOD + DM + c + 4) + 1.0f);
                    const f32x4 sa = *(const f32x4*)(modn + b5 * NMOD + c), sb = *(const f32x4*)(modn + b5 * NMOD + c + 4);
#pragma unroll
                    for (int ai = 0; ai < 2; ++ai)
#pragma unroll
                        for (int m = 0; m < 4; ++m) { const size_t off = (size_t)(row0 + ai * 128 + m * 16) * DM + c; const f32x4 na = acc[ai][bj][m][0], nb = acc[ai][bj][m][1];
                            u32x4 hi; u32x2 lo; xenc8(na, nb, hi, lo); *(u32x4*)(XH + off) = hi; *(u32x2*)(XL + off) = lo;
                            *(u32x4*)(H + off) = pack8(na * rs[ai][m] * ga + sa, nb * rs[ai][m] * gb + sb); }
                    asm volatile("" ::: "memory"); }
            }
        }
    }
};

namespace attn {
constexpr int QBLK = 32, KVBLK = 64;
constexpr size_t SHM_V = KVBLK * 128 * 2, SHM_K = KVBLK * 128 * 2, SHM_KR = KVBLK * 64 * 2;
constexpr int NST = 3;
constexpr size_t OFF_V = 0, OFF_K = NST * SHM_V, OFF_KR = OFF_K + NST * SHM_K, OFF_WS = OFF_KR + NST * SHM_KR, OFF_QR = OFF_WS + NWAVES * 64 * 4;
constexpr size_t OFF_OST = 0;
constexpr int OST_LD = 272;
constexpr size_t ATTN_LDS = OFF_QR + (size_t)NWAVES * 64 * 64;
static_assert((size_t)NWAVES * QBLK * OST_LD <= OFF_WS, "output staging must fit in the ring");
constexpr float THR = 8.f;
#define KSWZ(row, colB) ((row) * 256 + ((colB) ^ (((row) & 15) << 4)))
#define KRSWZ(row, colB) ((row) * 128 + ((colB) ^ ((((row) >> 1) & 7) << 4)))
__device__ __forceinline__ int crow(int r, int hi) { return (r & 3) + 8 * (r >> 2) + 4 * hi; }

template <bool MLA> struct Cfg { static constexpr float SCALE = MLA ? 0.07216878364870323f : 0.08838834764831845f; static constexpr int LDK = MLA ? 1024 : 256; };

__device__ __forceinline__ void partialSM_fixed(f32x16& p0, float off) {
#pragma unroll
    for (int r = 0; r < 16; ++r) p0[r] = __builtin_amdgcn_exp2f(p0[r]);
}
typedef __bf16 bf16x2_t __attribute__((ext_vector_type(2)));
__device__ __forceinline__ unsigned cvt_pk2(float lo, float hi) { const f32x2 v = {lo, hi}; const bf16x2_t b = __builtin_convertvector(v, bf16x2_t); return *reinterpret_cast<const unsigned*>(&b); }
template <bool FIXED>
__device__ __forceinline__ void finishSM(f32x16& p0, f32x16& p1, float alpha, float off, float& l_reg, bf16x8& pa0, bf16x8& pa1, bf16x8& pa2, bf16x8& pa3) {
#pragma unroll
    for (int r = 0; r < 16; ++r) p1[r] = __builtin_amdgcn_exp2f(p1[r]);
    float ps = 0;
#pragma unroll
    for (int r = 0; r < 16; ++r) ps += p0[r];
#pragma unroll
    for (int r = 0; r < 16; ++r) ps += p1[r];
    { auto rr = __builtin_amdgcn_permlane32_swap(__float_as_uint(ps), __float_as_uint(ps), false, false);
      ps = __uint_as_float(rr[0]) + __uint_as_float(rr[1]); }
    l_reg = FIXED ? l_reg + ps : l_reg * alpha + ps;
#define PK4(P, BASE, OUT) do { u32x4 w = {cvt_pk2(P[BASE + 0], P[BASE + 1]), cvt_pk2(P[BASE + 2], P[BASE + 3]), cvt_pk2(P[BASE + 4], P[BASE + 5]), cvt_pk2(P[BASE + 6], P[BASE + 7])};   \
    OUT = *reinterpret_cast<bf16x8*>(&w); } while (0)
    PK4(p0, 0, pa0); PK4(p0, 8, pa1); PK4(p1, 0, pa2); PK4(p1, 8, pa3);
#undef PK4
}
template <bool MLA>
__device__ __forceinline__ void qkt(f32x16& p0, f32x16& p1, const char* Ks, const char* Kr, const bf16x8* qr, const bf16x8* q2r, int r32, int hi, const f32x16& cinit) {
    p0 = cinit; p1 = cinit;
#pragma unroll
    for (int d0 = 0; d0 < 8; ++d0) { const int cb = (d0 * 16 + hi * 8) * 2;
        const bf16x8 b0 = *reinterpret_cast<const bf16x8*>(Ks + KSWZ(r32, cb));
        const bf16x8 b1 = *reinterpret_cast<const bf16x8*>(Ks + KSWZ(32 + r32, cb));
        p0 = __builtin_amdgcn_mfma_f32_32x32x16_bf16(b0, qr[d0], p0, 0, 0, 0);
        p1 = __builtin_amdgcn_mfma_f32_32x32x16_bf16(b1, qr[d0], p1, 0, 0, 0); }
    if constexpr (MLA) {
#pragma unroll
        for (int d0 = 0; d0 < 4; ++d0) { const int cb = (d0 * 16 + hi * 8) * 2;
            const bf16x8 b0 = *reinterpret_cast<const bf16x8*>(Kr + KRSWZ(r32, cb));
            const bf16x8 b1 = *reinterpret_cast<const bf16x8*>(Kr + KRSWZ(32 + r32, cb));
            const bf16x8 q2 = q2r[d0];
            p0 = __builtin_amdgcn_mfma_f32_32x32x16_bf16(b0, q2, p0, 0, 0, 0);
            p1 = __builtin_amdgcn_mfma_f32_32x32x16_bf16(b1, q2, p1, 0, 0, 0); }
    }
}
template <int OFF> __device__ __forceinline__ bf16x8 lds_rd(int a) { bf16x8 r; asm volatile("ds_read_b128 %0, %1 offset:%2" : "=v"(r) : "v"(a), "i"(OFF)); return r; }
template <int N> __device__ __forceinline__ void lds_wait(bf16x8& a, bf16x8& b) { asm volatile("s_waitcnt lgkmcnt(%2)" : "+v"(a), "+v"(b) : "i"(N)); }
template <bool MLA, bool FIXED>
__device__ __forceinline__ void qkt_fin(f32x16& y0, f32x16& y1, const char* Ks, const char* Kr, const bf16x8* qr, const bf16x8* q2r, int r32, int hi, const f32x16& cinit,
                                        f32x16& x0, f32x16& x1, float alpha, float& l_reg, bf16x8& pa0, bf16x8& pa1, bf16x8& pa2, bf16x8& pa3) {
    constexpr int NS = MLA ? 12 : 8;
    const int kx = (hi * 16) ^ ((r32 & 15) << 4), kbase = (int)(uintptr_t)Ks + r32 * 256;
    const int rx = (hi * 16) ^ (((r32 >> 1) & 7) << 4), rbase = (int)(uintptr_t)Kr + r32 * 128;
    bf16x8 ka[2], kb[2];
    y0 = cinit; y1 = cinit;
    float psa = 0.f, psb = 0.f; unsigned c0, c1, c2, c3;
#define QK_RD(s) do { if constexpr ((s) < 8) { const int a_ = kbase + (kx ^ ((s) * 32)); ka[(s) % 2] = lds_rd<0>(a_); kb[(s) % 2] = lds_rd<8192>(a_); }       \
        else if constexpr ((s) < NS) { const int a_ = rbase + (rx ^ (((s) - 8) * 32)); ka[(s) % 2] = lds_rd<0>(a_); kb[(s) % 2] = lds_rd<4096>(a_); } } while (0)
#define QK_RC(s) ((s) < NS ? 2 : 0)
#define FS_PK(X, B, OUT) do { u32x4 w_ = {c0, c1, c2, c3}; OUT = *reinterpret_cast<bf16x8*>(&w_); } while (0)
#define FS_SLOT(i) do { if constexpr ((i) < 16) { x1[(i)] = __builtin_amdgcn_exp2f(x1[(i)]); psa += x0[(i)]; if constexpr ((i) > 0) psb += x1[(i) - 1];                       \
        if constexpr ((i) < 8) { if constexpr (((i) & 3) == 0) c0 = cvt_pk2(x0[2 * (i)], x0[2 * (i) + 1]); else if constexpr (((i) & 3) == 1) c1 = cvt_pk2(x0[2 * (i)], x0[2 * (i) + 1]);           \
                                 else if constexpr (((i) & 3) == 2) c2 = cvt_pk2(x0[2 * (i)], x0[2 * (i) + 1]); else c3 = cvt_pk2(x0[2 * (i)], x0[2 * (i) + 1]);                                    \
                                 if constexpr ((i) == 3) FS_PK(x0, 0, pa0); if constexpr ((i) == 7) FS_PK(x0, 8, pa1); }                                                                           \
        else { constexpr int k_ = 2 * ((i) - 8);                                                                                                                                                 \
               if constexpr (((i) & 3) == 0) c0 = cvt_pk2(x1[k_], x1[k_ + 1]); else if constexpr (((i) & 3) == 1) c1 = cvt_pk2(x1[k_], x1[k_ + 1]);                                            \
               else if constexpr (((i) & 3) == 2) c2 = cvt_pk2(x1[k_], x1[k_ + 1]); else c3 = cvt_pk2(x1[k_], x1[k_ + 1]);                                                                    \
               if constexpr ((i) == 11) FS_PK(x1, 0, pa2); if constexpr ((i) == 15) FS_PK(x1, 8, pa3); } } } while (0)
#define QK_STEP(s) do { QK_RD((s) + 1); lds_wait<QK_RC((s) + 1)>(ka[(s) % 2], kb[(s) % 2]);                                                   \
        y0 = __builtin_amdgcn_mfma_f32_32x32x16_bf16(ka[(s) % 2], (s) < 8 ? qr[(s) < 8 ? (s) : 0] : q2r[(s) < 8 ? 0 : (MLA ? (s) - 8 : 0)], y0, 0, 0, 0); FS_SLOT(2 * (s)); SBAR();          \
        y1 = __builtin_amdgcn_mfma_f32_32x32x16_bf16(kb[(s) % 2], (s) < 8 ? qr[(s) < 8 ? (s) : 0] : q2r[(s) < 8 ? 0 : (MLA ? (s) - 8 : 0)], y1, 0, 0, 0); FS_SLOT(2 * (s) + 1); SBAR(); } while (0)
    QK_RD(0);
    QK_STEP(0); QK_STEP(1); QK_STEP(2); QK_STEP(3); QK_STEP(4); QK_STEP(5); QK_STEP(6); QK_STEP(7);
    if constexpr (MLA) { QK_STEP(8); QK_STEP(9); QK_STEP(10); QK_STEP(11); }
    psb += x1[15];
    float ps = psa + psb;
    { auto rr = __builtin_amdgcn_permlane32_swap(__float_as_uint(ps), __float_as_uint(ps), false, false); ps = __uint_as_float(rr[0]) + __uint_as_float(rr[1]); }
    l_reg = FIXED ? l_reg + ps : l_reg * alpha + ps;
#undef QK_RD
#undef QK_RC
#undef FS_PK
#undef FS_SLOT
#undef QK_STEP
}
__device__ __forceinline__ int v_st(int k, int c) { const int kk = (k & ~0xC) | ((k & 4) << 1) | ((k & 8) >> 1); return ((kk >> 3) * 4 + (c >> 5)) * 512 + ((kk & 7) * 32 + (c & 31)) * 2; }
__device__ __forceinline__ int v_rd_base(int lane) { return ((lane & 3) << 3) | (((lane >> 2) & 3) << 6) | (((lane >> 4) & 1) << 5) | (((lane >> 5) & 1) << 8); }
constexpr int v_rd_off(int d0, int ks, int half) { return d0 * 512 + ks * 4096 + half * 2048; }
template <int OFF> __device__ __forceinline__ s16x4 tr_read(int vb) {
    s16x4 r; asm volatile("ds_read_b64_tr_b16 %0, %1 offset:%2" : "=&v"(r) : "v"(vb), "i"(OFF) : "memory"); return r;
}
template <int D0> __device__ __forceinline__ void pv_one(f32x16& od, int vb, bf16x8 pa0, bf16x8 pa1, bf16x8 pa2, bf16x8 pa3) {
    const s16x4 l0 = tr_read<v_rd_off(D0, 0, 0)>(vb), h0 = tr_read<v_rd_off(D0, 0, 1)>(vb), l1 = tr_read<v_rd_off(D0, 1, 0)>(vb), h1 = tr_read<v_rd_off(D0, 1, 1)>(vb);
    const s16x4 l2 = tr_read<v_rd_off(D0, 2, 0)>(vb), h2 = tr_read<v_rd_off(D0, 2, 1)>(vb), l3 = tr_read<v_rd_off(D0, 3, 0)>(vb), h3 = tr_read<v_rd_off(D0, 3, 1)>(vb);
    asm volatile("s_waitcnt lgkmcnt(0)" ::: "memory"); SBAR();
#define PK(L, H) (bf16x8){L[0], L[1], L[2], L[3], H[0], H[1], H[2], H[3]}
    od = __builtin_amdgcn_mfma_f32_32x32x16_bf16(pa0, PK(l0, h0), od, 0, 0, 0);
    od = __builtin_amdgcn_mfma_f32_32x32x16_bf16(pa1, PK(l1, h1), od, 0, 0, 0);
    od = __builtin_amdgcn_mfma_f32_32x32x16_bf16(pa2, PK(l2, h2), od, 0, 0, 0);
    od = __builtin_amdgcn_mfma_f32_32x32x16_bf16(pa3, PK(l3, h3), od, 0, 0, 0);
#undef PK
}
__device__ __forceinline__ void pv_d0(f32x16* o, int vb, bf16x8 pa0, bf16x8 pa1, bf16x8 pa2, bf16x8 pa3) {
    pv_one<0>(o[0], vb, pa0, pa1, pa2, pa3); pv_one<1>(o[1], vb, pa0, pa1, pa2, pa3); pv_one<2>(o[2], vb, pa0, pa1, pa2, pa3); pv_one<3>(o[3], vb, pa0, pa1, pa2, pa3);
}

struct Item {
    const bf16_t* q;
    const bf16_t* q2;
    const bf16_t* k;
    const bf16_t* v;
    const bf16_t* k2;
    const bf16_t* gs;
    bf16_t* y;
    const float* qgain;
    const float* kgain;
    const f32x2* rope;
    int nkeys;
};

template <bool MLA>
__device__ __forceinline__ void attn_item(const Item& it, char* lds) {
    constexpr int LDK = Cfg<MLA>::LDK;
    constexpr int SD = MLA ? 1 : 2;
    const int tid = opaque_tid(), wid = tid >> 6, lane = tid & 63, r32 = lane & 31, hi = lane >> 5;
    char* V_lds = lds + OFF_V; char* K_lds = lds + OFF_K; char* KR_lds = lds + OFF_KR;
    float* ws = (float*)(lds + OFF_WS) + wid * 64; float* li_l = ws; float* al_l = ws + 32;
    float m_reg = 0.f, l_reg = 0; f32x16 o[4] = {}; bf16x8 qr[8];
    const char* qrl = lds + OFF_QR + wid * 4096 + lane * 16;
    bf16x8 q2v[MLA ? 4 : 1]; const bf16x8* q2r = q2v;
    const bf16_t* Kh = it.k; const bf16_t* Vh = it.v; const bf16_t* K2 = it.k2;
    const int vb0 = (int)(uintptr_t)V_lds + v_rd_base(lane);
    const int wv = __builtin_amdgcn_readfirstlane(wid);
    const int krow = 4 * wv + (lane >> 4);
    const unsigned gK = (unsigned)(krow * LDK + ((lane & 15) ^ (krow & 15)) * 8) * 2u;
    const int vblk = 2 * wv + (lane >> 5), vkk = (vblk >> 2) * 8 + ((lane >> 2) & 7), vk = vkk;
    const unsigned gV = (unsigned)(vk * LDK + (vblk & 3) * 32 + (lane & 3) * 8) * 2u;
    const int rrow = 8 * wv + (lane >> 3);
    const unsigned gR = (unsigned)(rrow * 64 + ((lane & 7) ^ ((rrow >> 1) & 7)) * 8) * 2u;
    LAS unsigned char* ldsl = (LAS unsigned char*)(uintptr_t)(unsigned)(uintptr_t)lds + wv * 1024;
    const __amdgpu_buffer_rsrc_t rK = __builtin_amdgcn_make_buffer_rsrc((void*)Kh, 0, 0x7fffffff, 0x00020000), rV = __builtin_amdgcn_make_buffer_rsrc((void*)Vh, 0, 0x7fffffff, 0x00020000);
    const __amdgpu_buffer_rsrc_t rR = __builtin_amdgcn_make_buffer_rsrc((void*)(MLA ? K2 : Kh), 0, 0x7fffffff, 0x00020000);
#define GLDS(rs, lp, vo, so) __builtin_amdgcn_raw_ptr_buffer_load_lds(rs, (LAS unsigned*)(lp), 16, (int)(vo), (int)(so), 0, 0)
#define DMA(b, k0) do { const unsigned so_ = (unsigned)(k0) * (unsigned)(LDK * 2);                                                                               \
    GLDS(rK, ldsl + OFF_K + (b) * (int)SHM_K, gK, so_); GLDS(rK, ldsl + OFF_K + (b) * (int)SHM_K + 8192, gK, so_ + 32u * LDK * 2u);                            \
    GLDS(rV, ldsl + OFF_V + (b) * (int)SHM_V, gV, so_); GLDS(rV, ldsl + OFF_V + (b) * (int)SHM_V + 8192, gV, so_ + 32u * LDK * 2u);                            \
    if constexpr (MLA) GLDS(rR, ldsl + OFF_KR + (b) * (int)SHM_KR, gR, (unsigned)(k0) * 128u); } while (0)
    __syncthreads();
    DMA(0, 0); DMA(1, KVBLK);
    float qsq = 0.f;
    {
        const bf16_t* Qw = it.q + (size_t)(wid * QBLK + r32) * 1024 + hi * 8;
#pragma unroll
        for (int d0 = 0; d0 < 8; ++d0) qr[d0] = *reinterpret_cast<const bf16x8*>(Qw + d0 * 16);
        if constexpr (MLA) {
            const bf16_t* Qw2 = it.q2 + (size_t)(wid * QBLK + r32) * 512 + hi * 8;
#pragma unroll
            for (int d0 = 0; d0 < 4; ++d0) { const bf16x8 t_ = *reinterpret_cast<const bf16x8*>(Qw2 + d0 * 16); q2v[d0] = t_;
#pragma unroll
                for (int e = 0; e < 8; ++e) { const float f_ = bf2f((unsigned short)t_[e]); qsq = fmaf(f_, f_, qsq); } }
        }
    }
#define RESC(a) do { } while (0)
#define NXT(b) ((b) == NST - 1 ? 0 : (b) + 1)
    f32x16 pA0, pA1, pB0, pB1; float mnA, mnB, alA = 1.f, alB = 1.f; bf16x8 pa0, pa1, pa2, pa3; const int NT = it.nkeys / KVBLK;
    float pinit = 0.f;
    if constexpr (!MLA) {
        float mq = fmaxf(fabsf(it.qgain[lane]), fabsf(it.qgain[lane + 64])), mk = fmaxf(fabsf(it.kgain[lane]), fabsf(it.kgain[lane + 64]));
#pragma unroll
        for (int o = 1; o < 64; o <<= 1) { mq = fmaxf(mq, __shfl_xor(mq, o)); mk = fmaxf(mk, __shfl_xor(mk, o)); }
        pinit = fmaxf(-(11.313708498984761f * 1.4426950408889634f * 1.0001f) * mq * mk, -60.f);
    }
    if constexpr (MLA) {
#pragma unroll
        for (int d0 = 0; d0 < 8; ++d0)
#pragma unroll
            for (int e = 0; e < 8; ++e) { const float f_ = bf2f((unsigned short)qr[d0][e]); qsq = fmaf(f_, f_, qsq); }
        { auto rr = __builtin_amdgcn_permlane32_swap(__float_as_uint(qsq), __float_as_uint(qsq), false, false); qsq = __uint_as_float(rr[0]) + __uint_as_float(rr[1]); }
        float kr2 = fmaxf(fmaxf(it.kgain[lane], it.kgain[lane + 64]), fmaxf(it.kgain[lane + 128], it.kgain[lane + 192]));
#pragma unroll
        for (int o = 1; o < 64; o <<= 1) kr2 = fmaxf(kr2, __shfl_xor(kr2, o));
        const int j_ = lane & 15, g_ = lane >> 4;
        float kn2 = j_ < 9 ? fmaxf(it.qgain[(g_ * 2) * 16 + j_], it.qgain[(g_ * 2 + 1) * 16 + j_]) : 0.f;
        kn2 = fmaxf(kn2, __shfl_xor(kn2, 1)); kn2 = fmaxf(kn2, __shfl_xor(kn2, 2)); kn2 = fmaxf(kn2, __shfl_xor(kn2, 4)); kn2 = fmaxf(kn2, __shfl_xor(kn2, 8));
        kn2 += __shfl_xor(kn2, 16); kn2 += __shfl_xor(kn2, 32);
        const float k2 = kn2 + fmaxf(kr2, 0.f);
        pinit = fmaxf(-1.01f * __builtin_sqrtf(qsq * k2), -60.f);
    }
    f32x16 cinit;
#pragma unroll
    for (int r = 0; r < 16; ++r) cinit[r] = pinit;
    asm volatile("" : "+v"(cinit));
#define PSM(p0, p1, mn, al) partialSM_fixed(p0, pinit)
#define PSM1(p0, p1, mn, al) partialSM_fixed(p0, pinit)
    asm volatile("s_waitcnt vmcnt(0)" ::: "memory"); __syncthreads();
    qkt<MLA>(pA0, pA1, K_lds, KR_lds, qr, q2r, r32, hi, cinit); PSM1(pA0, pA1, mnA, alA);
#define WGBAR() do { asm volatile("s_waitcnt vmcnt(0) lgkmcnt(0)" ::: "memory"); __builtin_amdgcn_s_barrier(); asm volatile("" ::: "memory"); } while (0)
    int b0 = 0;
    for (int j = 0; j + 2 < NT; j += 2) {
        const int b1 = NXT(b0), b2 = NXT(b1);
        DMA(b2, (j + 2) * KVBLK); SBAR();
        if constexpr (!MLA) qkt_fin<MLA, !MLA>(pB0, pB1, K_lds + b1 * (int)SHM_K, KR_lds + b1 * (int)SHM_KR, qr, q2r, r32, hi, cinit, pA0, pA1, alA, l_reg, pa0, pa1, pa2, pa3);
        else { qkt<MLA>(pB0, pB1, K_lds + b1 * (int)SHM_K, KR_lds + b1 * (int)SHM_KR, qr, q2r, r32, hi, cinit); finishSM<true>(pA0, pA1, alA, pinit, l_reg, pa0, pa1, pa2, pa3); } SBAR();
        pv_d0(o, vb0 + b0 * (int)SHM_V, pa0, pa1, pa2, pa3);
        PSM(pB0, pB1, mnB, alB); RESC(alB);
        WGBAR();
        DMA(b0, (j + 3) * KVBLK); SBAR();
        if constexpr (!MLA) qkt_fin<MLA, !MLA>(pA0, pA1, K_lds + b2 * (int)SHM_K, KR_lds + b2 * (int)SHM_KR, qr, q2r, r32, hi, cinit, pB0, pB1, alB, l_reg, pa0, pa1, pa2, pa3);
        else { qkt<MLA>(pA0, pA1, K_lds + b2 * (int)SHM_K, KR_lds + b2 * (int)SHM_KR, qr, q2r, r32, hi, cinit); finishSM<true>(pB0, pB1, alB, pinit, l_reg, pa0, pa1, pa2, pa3); } SBAR();
        pv_d0(o, vb0 + b1 * (int)SHM_V, pa0, pa1, pa2, pa3);
        PSM(pA0, pA1, mnA, alA); RESC(alA);
        WGBAR();
        b0 = b2;
    }
    {
        const int b1 = NXT(b0);
        SBAR(); qkt<MLA>(pB0, pB1, K_lds + b1 * (int)SHM_K, KR_lds + b1 * (int)SHM_KR, qr, q2r, r32, hi, cinit);
        finishSM<true>(pA0, pA1, alA, pinit, l_reg, pa0, pa1, pa2, pa3); SBAR();
        pv_d0(o, vb0 + b0 * (int)SHM_V, pa0, pa1, pa2, pa3); PSM(pB0, pB1, mnB, alB);
        RESC(alB);
        finishSM<true>(pB0, pB1, alB, pinit, l_reg, pa0, pa1, pa2, pa3); SBAR();
        pv_d0(o, vb0 + b1 * (int)SHM_V, pa0, pa1, pa2, pa3);
    }
    __syncthreads();
    if (hi == 0) li_l[r32] = l_reg; asm volatile("s_waitcnt lgkmcnt(0)" ::: "memory");
    {
        char* ost = lds + OFF_OST + wid * (QBLK * OST_LD);
        const int err = lane >> 4, ech = lane & 15;
        const bf16_t* Gw = it.gs + (size_t)(wid * QBLK + err) * DM + ech * 8; bf16_t* Yw = it.y + (size_t)(wid * QBLK + err) * DM + ech * 8;
        u32x4 gv[4];
#pragma unroll
        for (int c = 0; c < 4; ++c) gv[c] = *(const u32x4*)(Gw + (size_t)c * 4 * DM);
        const bool odd = lane & 1;
#pragma unroll
        for (int r = 0; r < 16; ++r) { const int orow = crow(r, hi); const float rl = __builtin_amdgcn_rcpf(li_l[orow]);
#pragma unroll
            for (int d0 = 0; d0 < 4; ++d0) { const float val = o[d0][r] * rl;
                const float nb = __int_as_float(__builtin_amdgcn_mov_dpp(__float_as_int(val), 0xB1, 0xF, 0xF, true));
                const unsigned pk = cvt_pk_bf16(val, nb);
                if (!odd) *(unsigned*)(ost + orow * OST_LD + (d0 * 32 + r32) * 2) = pk; } }
        asm volatile("s_waitcnt lgkmcnt(0)" ::: "memory");
        const char* orp = ost + err * OST_LD + ech * 16;
#pragma unroll
        for (int c = 0; c < 4; ++c) { const u32x4 ov = *(const u32x4*)(orp + c * 4 * OST_LD); u32x4 yv;
#pragma unroll
            for (int j = 0; j < 4; ++j) yv[j] = cvt_pk_bf16(bflo(ov[j]) * bflo(gv[c][j]), bfhi(ov[j]) * bfhi(gv[c][j]));
            *(u32x4*)(Yw + (size_t)c * 4 * DM) = yv; gv[c] = *(const u32x4*)(Gw + (size_t)(c + 4) * 4 * DM); }
#pragma unroll
        for (int c = 4; c < 8; ++c) { const u32x4 ov = *(const u32x4*)(orp + c * 4 * OST_LD); u32x4 yv;
#pragma unroll
            for (int j = 0; j < 4; ++j) yv[j] = cvt_pk_bf16(bflo(ov[j]) * bflo(gv[c - 4][j]), bfhi(ov[j]) * bfhi(gv[c - 4][j]));
            *(u32x4*)(Yw + (size_t)c * 4 * DM) = yv; }
    }
#undef PSM
#undef PSM1
#undef DMA
#undef GLDS
#undef NXT
#undef WGBAR
#undef RESC
}
}
static_assert(attn::ATTN_LDS <= (size_t)LDSCTL_OFF, "attention LDS");

struct Frame {
    LAS unsigned char* lds; char* ldsg;
    int tid, lane, wave, G, bid;
    unsigned char* ws;
    __device__ __forceinline__ void refresh(KP P) { tid = opaque_tid(); lane = tid & 63; wave = __builtin_amdgcn_readfirstlane(tid >> 6); ws = P->ws; }
};

__device__ __forceinline__ void p_mod(Frame& F, int l, int worker, int nworkers) {
    const KP P = kparams(); F.refresh(P);
    float* sc = (float*)F.ldsg; float* red = (float*)(F.ldsg + 40960);
    float* MOD = (float*)(F.ws + WS_MOD);
    __syncthreads();
    for (int i = F.tid; i < 5 * DM; i += NTHREADS) { const int r = i >> 11, k = i & 2047; const float v = r < 4 ? P->c[r * DM + k] : P->c_ctx[k]; sc[i] = v / (1.0f + __expf(-v)); }
    __syncthreads();
    const int krow = F.lane >> 3, c4 = (F.lane & 7) * 4;
    for (int cgp = worker; cgp < 192; cgp += nworkers) {
        const float* W = P->w_ada + (size_t)l * DM * NMOD + cgp * 32 + c4;
        float acc[5][4];
#pragma unroll
        for (int r = 0; r < 5; ++r)
#pragma unroll
            for (int j = 0; j < 4; ++j) acc[r][j] = 0.f;
#pragma unroll 8
        for (int i = 0; i < 32; ++i) { const int k = F.wave * 256 + i * 8 + krow; const f32x4 w = __builtin_nontemporal_load((const f32x4*)(W + (size_t)k * NMOD));
#pragma unroll
            for (int r = 0; r < 5; ++r) { const float s = sc[r * DM + k];
#pragma unroll
                for (int j = 0; j < 4; ++j) acc[r][j] = fmaf(s, w[j], acc[r][j]); } }
#pragma unroll
        for (int r = 0; r < 5; ++r)
#pragma unroll
            for (int j = 0; j < 4; ++j) { float v = acc[r][j]; v += __shfl_xor(v, 8); v += __shfl_xor(v, 16); v += __shfl_xor(v, 32);
                if (F.lane < 8) red[(F.wave * 5 + r) * 32 + c4 + j] = v; }
        __syncthreads();
        if (F.tid < 160) { const int r = F.tid >> 5, cc = F.tid & 31; float s = 0.f;
#pragma unroll
            for (int w = 0; w < 8; ++w) s += red[(w * 5 + r) * 32 + cc];
            MOD[(size_t)(l * 5 + r) * NMOD + cgp * 32 + cc] = s + P->b_ada[l * NMOD + cgp * 32 + cc]; }
        __syncthreads();
    }
}
__device__ __forceinline__ void transpose_item(const float* W, int K, int N, bf16_t* WT, int k0, int n0, int drow0, int dsplit, const float* gain, float* scr, int lane) {
    const int lr = lane >> 4, lc = (lane & 15) * 4;
    f32x4 v[16];
#pragma unroll
    for (int i = 0; i < 16; ++i) v[i] = __builtin_nontemporal_load((const f32x4*)(W + (size_t)(k0 + 4 * i + lr) * N + n0 + lc));
#pragma unroll
    for (int i = 0; i < 16; ++i) { const int kk = 4 * i + lr; const float g = gain ? gain[k0 + kk] : 1.0f; float* s = scr + kk * 65 + lc;
        s[0] = v[i][0] * g; s[1] = v[i][1] * g; s[2] = v[i][2] * g; s[3] = v[i][3] * g; }
    LDS_WAIT(); asm volatile("" ::: "memory");
    const int c = lane & 7;
#pragma unroll
    for (int j = 0; j < 8; ++j) { const int n = (lane >> 3) + 8 * j; const float* s = scr + (8 * c) * 65 + n;
        u32x4 o; o.x = cvt_pk_bf16(s[0 * 65], s[1 * 65]); o.y = cvt_pk_bf16(s[2 * 65], s[3 * 65]); o.z = cvt_pk_bf16(s[4 * 65], s[5 * 65]); o.w = cvt_pk_bf16(s[6 * 65], s[7 * 65]);
        const int dr = (n < 32 || dsplit == 0) ? drow0 + n : drow0 + dsplit + (n - 32);
        *(u32x4*)(WT + (size_t)dr * K + k0 + 8 * c) = o; }
    LDS_WAIT(); asm volatile("" ::: "memory");
}
__device__ __forceinline__ void p_weights(Frame& F, int l, int worker, int nworkers, int part) {
    const KP P = kparams(); F.refresh(P);
    float* scr = (float*)(F.ldsg) + F.wave * (64 * 65);
    const int gw = worker * NWAVES + F.wave, NGW = nworkers * NWAVES;
    constexpr int I_IN = 32 * 73, I_UQ = 8 * 24, I_UKV = 8 * 32, I_OUT = 32 * 32, I_L = I_IN + I_UQ + I_UKV + I_OUT;
    const int it_lo = part == 2 ? I_IN : 0, it_hi = part == 1 ? I_IN : I_L;
    for (int it = it_lo + gw; it < it_hi; it += NGW) {
        int r = it;
        if (r < I_IN) { const int kb = r / 73, nb = r % 73, n0 = nb * 64;
            const int d0 = n0 < 3584 ? n0 : (n0 < 3648 ? 4608 + (n0 - 3584) : n0 - 64);
            transpose_item(P->w_in + (size_t)l * DM * D_IN, DM, D_IN, (bf16_t*)(F.ws + WS_W1 + l * W1_L), kb * 64, n0, d0, 0, nullptr, scr, F.lane); continue; }
        r -= I_IN;
        if (r < I_UQ) { const int kb = r / 24, nb = r % 24, n0 = nb * 64, head = n0 / 192, e = n0 % 192;
            const int d0 = e < 128 ? head * 128 + e : 1024 + (head >> 2) * 256 + (head & 3) * 32;
            transpose_item(P->w_uq + (size_t)l * 512 * 1536, 512, 1536, (bf16_t*)(F.ws + WS_W2A + l * W2A_L), kb * 64, n0, d0, e < 128 ? 0 : 128, P->cq_gain + l * 512, scr, F.lane); continue; }
        r -= I_UQ;
        if (r < I_UKV) { const int kb = r / 32, nb = r % 32, n0 = nb * 64;
            transpose_item(P->w_ukv + (size_t)l * 512 * 2048, 512, 2048, (bf16_t*)(F.ws + WS_W2B + l * W2B_L), kb * 64, n0, n0, 0, P->ckv_gain + l * 512, scr, F.lane); continue; }
        r -= I_UKV;
        { const int kb = r / 32, nb = r % 32, n0 = nb * 64;
            transpose_item(P->w_out + (size_t)l * DM * DM, DM, DM, (bf16_t*)(F.ws + WS_W3 + l * W3_L), kb * 64, n0, n0, 0, nullptr, scr, F.lane); }
    }
    const int gt = worker * NTHREADS + F.tid, NGT = nworkers * NTHREADS;
    constexpr int PADV = 192 * DM * 2 / 16;
    if (part != 2) { unsigned z; asm volatile("v_mov_b32 %0, 0" : "=v"(z));
        for (int i = gt; i < PADV; i += NGT) *(u32x4*)(F.ws + WS_W1 + l * W1_L + (size_t)D_IN * DM * 2 + (size_t)i * 16) = (u32x4){z, z, z, z}; }
}
__device__ __forceinline__ void p_rope(Frame& F) {
    const KP P = kparams(); F.refresh(P);
    const int gt = F.bid * NTHREADS + F.tid, NGT = F.G * NTHREADS;
    f32x2* RG = (f32x2*)(F.ws + WS_ROPEG); f32x2* RM = (f32x2*)(F.ws + WS_ROPEM);
    for (int i = gt; i < SEQ * 96; i += NGT) {
        const int s = i / 96, e = i % 96; const int row = s >> 6, col = s & 63;
        float ang; f32x2* dst;
        if (e < 64) { const int f = e & 31; const float inv = exp2f(-(float)f * (13.287712379549449f / 32.0f)); ang = (float)(e < 32 ? row : col) * inv; dst = RG + (size_t)s * 64 + e; }
        else { const int e2 = e - 64, f = e2 & 15; const float inv = exp2f(-(float)f * (13.287712379549449f / 16.0f)); ang = (float)(e2 < 16 ? row : col) * inv; dst = RM + (size_t)s * 32 + e2; }
        const float tr = ang * 0.15915494309189535f; const float fr = tr - floorf(tr);
        f32x2 o; o.x = __builtin_amdgcn_cosf(fr); o.y = __builtin_amdgcn_sinf(fr); *dst = o;
    }
}

__device__ __forceinline__ void p_norm(Frame& F, int l, int rlo) {
    const KP P = kparams(); F.refresh(P);
    const int gw = F.bid * NWAVES + F.wave, NGW = F.G * NWAVES;
    const float* MOD = (const float*)(F.ws + WS_MOD) + (size_t)l * 5 * NMOD;
    const float* ng = P->norm_g + l * DM;
    bf16_t* H = (bf16_t*)(F.ws + WS_H);
    const float* xc = l <= 1 ? P->ctx : (const float*)(F.ws + WS_XC);
    const bf16_t* XH = (const bf16_t*)(F.ws + WS_XH); const unsigned char* XL = F.ws + WS_XL;
    const bf16_t* slab = (const bf16_t*)(F.ws + WS_SLAB); float* xcw = (float*)(F.ws + WS_XC);
    const float* gprev = MOD - 5 * NMOD + 4 * NMOD + 2 * DM;
    for (int r = rlo + gw; r < MROWS; r += NGW) {
        const int b5 = r < NLAT ? (r >> 11) : 4;
        f32x4 va[4], vb[4]; float ss = 0.f;
        if (r < NLAT && l > 0) {
#pragma unroll
            for (int j = 0; j < 4; ++j) { const size_t o = (size_t)r * DM + (F.lane + 64 * j) * 8; xdec8(*(const u32x4*)(XH + o), *(const u32x2*)(XL + o), va[j], vb[j]); }
        } else {
            const float* xr = r < NLAT ? P->x + (size_t)r * DM : xc + (size_t)(r - NLAT) * DM;
#pragma unroll
            for (int j = 0; j < 4; ++j) { va[j] = *(const f32x4*)(xr + (F.lane + 64 * j) * 8); vb[j] = *(const f32x4*)(xr + (F.lane + 64 * j) * 8 + 4); }
        }
        if (l > 0 && r >= NLAT) {
#pragma unroll
            for (int j = 0; j < 4; ++j) { const int k = (F.lane + 64 * j) * 8; const size_t o = (size_t)(r - NLAT) * DM + k; const u32x4 w0 = *(const u32x4*)(slab + o); f32x4 sa = {bflo(w0.x), bfhi(w0.x), bflo(w0.y), bfhi(w0.y)}, sb = {bflo(w0.z), bfhi(w0.z), bflo(w0.w), bfhi(w0.w)};
#pragma unroll
                for (int ks = 1; ks < 8; ++ks) { const u32x4 w = *(const u32x4*)(slab + (size_t)ks * NCTX * DM + o);
                    sa[0] += bflo(w.x); sa[1] += bfhi(w.x); sa[2] += bflo(w.y); sa[3] += bfhi(w.y); sb[0] += bflo(w.z); sb[1] += bfhi(w.z); sb[2] += bflo(w.w); sb[3] += bfhi(w.w); }
                va[j] += *(const f32x4*)(gprev + k) * sa; vb[j] += *(const f32x4*)(gprev + k + 4) * sb; *(f32x4*)(xcw + o) = va[j]; *(f32x4*)(xcw + o + 4) = vb[j]; }
        }
#pragma unroll
        for (int j = 0; j < 4; ++j) ss += ((va[j][0] * va[j][0] + va[j][1] * va[j][1]) + (va[j][2] * va[j][2] + va[j][3] * va[j][3])) + ((vb[j][0] * vb[j][0] + vb[j][1] * vb[j][1]) + (vb[j][2] * vb[j][2] + vb[j][3] * vb[j][3]));
        const float rs = rsqrtf(wave_sum(ss) * (1.0f / DM) + EPS);
        const float* msh = MOD + b5 * NMOD; const float* msc = msh + DM;
#pragma unroll
        for (int j = 0; j < 4; ++j) { const int k = (F.lane + 64 * j) * 8;
            const f32x4 ga = *(const f32x4*)(ng + k) * (*(const f32x4*)(msc + k) + 1.0f), gb = *(const f32x4*)(ng + k + 4) * (*(const f32x4*)(msc + k + 4) + 1.0f);
            const f32x4 ha = va[j] * rs * ga + *(const f32x4*)(msh + k), hb = vb[j] * rs * gb + *(const f32x4*)(msh + k + 4);
            *(u32x4*)(H + (size_t)r * DM + k) = pack8(ha, hb); }
    }
}
__device__ __forceinline__ void p_final(Frame& F) {
    const KP P = kparams(); F.refresh(P);
    const int gw = F.bid * NWAVES + F.wave, NGW = F.G * NWAVES;
    const bf16_t* XH = (const bf16_t*)(F.ws + WS_XH); const unsigned char* XL = F.ws + WS_XL;
    for (int r = gw; r < NLAT; r += NGW) {
        f32x4 va[4], vb[4]; float ss = 0.f;
#pragma unroll
        for (int j = 0; j < 4; ++j) { const size_t o = (size_t)r * DM + (F.lane + 64 * j) * 8; xdec8(*(const u32x4*)(XH + o), *(const u32x2*)(XL + o), va[j], vb[j]);
            ss += ((va[j][0] * va[j][0] + va[j][1] * va[j][1]) + (va[j][2] * va[j][2] + va[j][3] * va[j][3])) + ((vb[j][0] * vb[j][0] + vb[j][1] * vb[j][1]) + (vb[j][2] * vb[j][2] + vb[j][3] * vb[j][3])); }
        const float rs = rsqrtf(wave_sum(ss) * (1.0f / DM) + EPS);
        float* orow = P->out + (size_t)r * DM;
#pragma unroll
        for (int j = 0; j < 4; ++j) { const int k = (F.lane + 64 * j) * 8;
            *(f32x4*)(orow + k) = va[j] * rs * *(const f32x4*)(P->final_g + k); *(f32x4*)(orow + k + 4) = vb[j] * rs * *(const f32x4*)(P->final_g + k + 4); }
    }
}

__device__ __forceinline__ void p_kfin(Frame& F, int l) {
    const KP P = kparams(); F.refresh(P);
    const int gw = F.bid * NWAVES + F.wave, NGW = F.G * NWAVES;
    const bf16_t* KG = (const bf16_t*)(F.ws + WS_KG); const bf16_t* KR = (const bf16_t*)(F.ws + WS_KR);
    bf16_t* KGF = (bf16_t*)(F.ws + WS_KGF); bf16_t* KRF = (bf16_t*)(F.ws + WS_KRF);
    const f32x2* RG = (const f32x2*)(F.ws + WS_ROPEG); const f32x2* RM = (const f32x2*)(F.ws + WS_ROPEM);
    const int lane = F.lane, hl = lane & 31, d = hl * 4;
    const f32x4 kg = *(const f32x4*)(P->k_gain + l * 128 + d);
    const bf16_t* QG = (const bf16_t*)(F.ws + WS_QG); bf16_t* QGF = (bf16_t*)(F.ws + WS_QGF);
    const int qh = lane >> 3, s8 = lane & 7;
    const float* qgp = P->q_gain + l * 128 + s8 * 8;
    const f32x4 qg0 = *(const f32x4*)(qgp), qg1 = *(const f32x4*)(qgp + 4), qg2 = *(const f32x4*)(qgp + 64), qg3 = *(const f32x4*)(qgp + 68);
    float kb0 = 0.f, kb1 = 0.f, kb2 = 0.f, kb3 = 0.f;
    for (int r = gw; r < MROWS; r += NGW) {
        const int kvr = kvrow_of(r); const bool lat = r < NLAT; const int s = r & 2047;
        {
            const bf16_t* qp = QG + (size_t)r * 1024 + qh * 128 + s8 * 8;
            const u32x4 w1 = *(const u32x4*)(qp), w2 = *(const u32x4*)(qp + 64);
            float x1[8], x2[8]; float qs = 0.f;
#pragma unroll
            for (int j = 0; j < 4; ++j) { x1[2 * j] = bflo(w1[j]); x1[2 * j + 1] = bfhi(w1[j]); x2[2 * j] = bflo(w2[j]); x2[2 * j + 1] = bfhi(w2[j]); }
#pragma unroll
            for (int j = 0; j < 8; ++j) qs += x1[j] * x1[j] + x2[j] * x2[j];
            qs += __shfl_xor(qs, 1); qs += __shfl_xor(qs, 2); qs += __shfl_xor(qs, 4);
            const float qrs = rsqrtf(qs * (1.0f / 128.0f) + EPS) * (0.08838834764831845f * 1.4426950408889634f);
#pragma unroll
            for (int j = 0; j < 4; ++j) { x1[j] *= qrs * qg0[j]; x1[4 + j] *= qrs * qg1[j]; x2[j] *= qrs * qg2[j]; x2[4 + j] *= qrs * qg3[j]; }
            if (lat) { const f32x2* cs = RG + (size_t)s * 64 + s8 * 8;
#pragma unroll
                for (int j = 0; j < 8; ++j) { const f32x2 t = cs[j]; const float a = x1[j], b = x2[j]; x1[j] = a * t.x - b * t.y; x2[j] = b * t.x + a * t.y; } }
            u32x4 o1, o2;
#pragma unroll
            for (int j = 0; j < 4; ++j) { o1[j] = cvt_pk_bf16(x1[2 * j], x1[2 * j + 1]); o2[j] = cvt_pk_bf16(x2[2 * j], x2[2 * j + 1]); }
            bf16_t* qo = QGF + (size_t)r * 1024 + qh * 128 + s8 * 8;
            *(u32x4*)(qo) = o1; *(u32x4*)(qo + 64) = o2;
        }
        const u32x2 w = *(const u32x2*)(KG + (size_t)r * 256 + lane * 4);
        float x[4] = {bflo(w.x), bfhi(w.x), bflo(w.y), bfhi(w.y)};
        float ss = (x[0] * x[0] + x[1] * x[1]) + (x[2] * x[2] + x[3] * x[3]);
#pragma unroll
        for (int o = 1; o < 32; o <<= 1) ss += __shfl_xor(ss, o);
        const float rs = rsqrtf(ss * (1.0f / 128.0f) + EPS);
#pragma unroll
        for (int e = 0; e < 4; ++e) x[e] *= rs * kg[e];
        float px[4];
#pragma unroll
        for (int e = 0; e < 4; ++e) px[e] = __shfl_xor(x[e], 16);
        if (lat) {
            const int i = (hl & 15) * 4;
            const f32x2* cs = RG + (size_t)s * 64 + i;
#pragma unroll
            for (int e = 0; e < 4; ++e) { const f32x2 t = cs[e]; x[e] = (hl < 16) ? (x[e] * t.x - px[e] * t.y) : (x[e] * t.x + px[e] * t.y); }
        }
        u32x2 ow; ow.x = cvt_pk_bf16(x[0], x[1]); ow.y = cvt_pk_bf16(x[2], x[3]);
        *(u32x2*)(KGF + (size_t)kvr * 256 + lane * 4) = ow;
        {
            const int l16 = lane & 15;
            const u32x2 w2 = *(const u32x2*)(KR + (size_t)r * 64 + l16 * 4);
            float y[4] = {bflo(w2.x), bfhi(w2.x), bflo(w2.y), bfhi(w2.y)}; float py[4];
#pragma unroll
            for (int e = 0; e < 4; ++e) py[e] = __shfl_xor(y[e], 8);
            if (lat) { const int i = (l16 & 7) * 4; const f32x2* cs = RM + (size_t)s * 32 + i;
#pragma unroll
                for (int e = 0; e < 4; ++e) { const f32x2 t = cs[e]; y[e] = (l16 < 8) ? (y[e] * t.x - py[e] * t.y) : (y[e] * t.x + py[e] * t.y); } }
            if (lane < 16) { u32x2 o2; o2.x = cvt_pk_bf16(y[0], y[1]); o2.y = cvt_pk_bf16(y[2], y[3]); *(u32x2*)(KRF + (size_t)kvr * 64 + l16 * 4) = o2; }
            float ks = (y[0] * y[0] + y[1] * y[1]) + (y[2] * y[2] + y[3] * y[3]);
            ks += __shfl_xor(ks, 1); ks += __shfl_xor(ks, 2); ks += __shfl_xor(ks, 4); ks += __shfl_xor(ks, 8);
            { const int b_ = lat ? (r >> 11) : ((r - NLAT) >> 8); kb0 = b_ == 0 ? fmaxf(kb0, ks) : kb0; kb1 = b_ == 1 ? fmaxf(kb1, ks) : kb1; kb2 = b_ == 2 ? fmaxf(kb2, ks) : kb2; kb3 = b_ == 3 ? fmaxf(kb3, ks) : kb3; }
        }
    }
    {
        float* red = (float*)F.ldsg;
        __syncthreads();
        if (lane == 0) { red[F.wave * 4 + 0] = kb0; red[F.wave * 4 + 1] = kb1; red[F.wave * 4 + 2] = kb2; red[F.wave * 4 + 3] = kb3; }
        __syncthreads();
        if (F.tid < 4) { float m = red[F.tid];
#pragma unroll
            for (int w = 1; w < NWAVES; ++w) m = fmaxf(m, red[w * 4 + F.tid]);
            ((float*)(F.ws + WS_CTL + CTL_KRMAX))[(l * 4 + F.tid) * 256 + (F.bid & 255)] = m; }
        __syncthreads();
    }
}

__device__ __forceinline__ void p_attn(Frame& F, int l) {
    const KP P = kparams(); F.refresh(P);
    const bf16_t* QG = (const bf16_t*)(F.ws + WS_QGF); const bf16_t* KGF = (const bf16_t*)(F.ws + WS_KGF); const bf16_t* VG = (const bf16_t*)(F.ws + WS_VG);
    const bf16_t* QMN = (const bf16_t*)(F.ws + WS_QMN); const bf16_t* QMR = (const bf16_t*)(F.ws + WS_QMR);
    const bf16_t* KMN = (const bf16_t*)(F.ws + WS_KMN); const bf16_t* VM = (const bf16_t*)(F.ws + WS_VM); const bf16_t* KRF = (const bf16_t*)(F.ws + WS_KRF);
    const bf16_t* GS = (const bf16_t*)(F.ws + WS_GS); bf16_t* Y = (bf16_t*)(F.ws + WS_Y);
    const f32x2* RG = (const f32x2*)(F.ws + WS_ROPEG);
    const int nitems = (l < DEPTH - 1) ? 576 : 512;
    for (int i = F.bid; i < nitems; i += F.G) {
        attn::Item it; bool mla; int b, h, row0, nk; const f32x2* rope = nullptr;
        if (i < 256) { const int x = i & 7, j = i >> 3; b = x >> 1; h = (x & 1) * 4 + (j >> 3); const int qb = j & 7; mla = false; row0 = b * SEQ + qb * 256; nk = NKEY; rope = RG + (size_t)(qb * 256) * 64; }
        else if (i < 512) { const int ii = i - 256, x = ii & 7, j = ii >> 3, combo = x * 4 + (j >> 3); b = combo >> 3; h = combo & 7; const int qb = j & 7; mla = true; row0 = b * SEQ + qb * 256; nk = NKEY; }
        else if (i < 544) { const int ii = i - 512; b = ii >> 3; h = ii & 7; mla = false; row0 = NLAT + b * CTXL; nk = CTXL; }
        else { const int ii = i - 544; b = ii >> 3; h = ii & 7; mla = true; row0 = NLAT + b * CTXL; nk = CTXL; }
        it.nkeys = nk; it.rope = rope; it.qgain = P->q_gain + l * 128; it.kgain = P->k_gain + l * 128;
        if (!mla) {
            it.q = QG + (size_t)row0 * 1024 + h * 128; it.q2 = nullptr;
            it.k = KGF + (size_t)b * NKEY * 256 + (h >> 2) * 128; it.v = VG + (size_t)b * NKEY * 256 + (h >> 2) * 128; it.k2 = nullptr;
            it.gs = GS + (size_t)row0 * DM + h * 128; it.y = Y + (size_t)row0 * DM + h * 128;
            attn::attn_item<false>(it, F.ldsg);
        } else {
            it.qgain = (const float*)(F.ws + WS_CTL + CTL_KMAX) + ((l * 4 + b) * 8 + h) * (4 * 2 * 16); it.kgain = (const float*)(F.ws + WS_CTL + CTL_KRMAX) + (l * 4 + b) * 256;
            it.q = QMN + (size_t)row0 * 1024 + h * 128; it.q2 = QMR + (size_t)row0 * 512 + h * 64;
            it.k = KMN + (size_t)b * NKEY * 1024 + h * 128; it.v = VM + (size_t)b * NKEY * 1024 + h * 128; it.k2 = KRF + (size_t)b * NKEY * 64;
            it.gs = GS + (size_t)row0 * DM + 1024 + h * 128; it.y = Y + (size_t)row0 * DM + 1024 + h * 128;
            attn::attn_item<true>(it, F.ldsg);
        }
    }
}

constexpr int N_PHASES = 2 + 5 * DEPTH;

__global__ void __launch_bounds__(NTHREADS, 2) fwd_kernel(Params Pv) {
    extern __shared__ __attribute__((aligned(16))) unsigned char lds[];
    Frame F;
    F.lds = (LAS unsigned char*)lds; F.ldsg = (char*)lds;
    F.G = gridDim.x; F.bid = blockIdx.x;
    { const KP P = kparams(); F.refresh(P); }
#if MK_ONE_LAUNCH
    cg::grid_group grid = cg::this_grid();
    volatile LAS unsigned* MISC = (volatile LAS unsigned*)(F.lds + MISC_OFF);
    for (int u = F.tid; u < (LDS_BYTES - LDSCTL_OFF) / 4; u += NTHREADS) ((LAS unsigned*)(F.lds + LDSCTL_OFF))[u] = 0u;
    __syncthreads();
    const XcdBarrier bar = xcd_barrier_post((unsigned*)(F.ws + WS_CTL) + CW_BAR, MISC + 8);
#define GRID_BAR() xcd_barrier(bar)
#define GRID_BAR0() xcd_barrier(bar)
    (void)grid;
#else
#define GRID_BAR() do {} while (0)
#define GRID_BAR0() do {} while (0)
#endif
    int lo, hi; { const KP P = kparams(); lo = P->ph_lo; hi = P->ph_hi; }
#define IN(k) (lo <= (k) && (k) < hi)
    if (IN(0)) { p_rope(F); p_weights(F, 0, F.bid, F.G, 0);
        if (F.G <= 64) { for (int l = 1; l < DEPTH; ++l) { p_weights(F, l, F.bid, F.G, 2); p_mod(F, l, F.bid, F.G); } }
        p_mod(F, 0, F.bid, F.G);
        GRID_BAR0(); }
    for (int l = 0; l < DEPTH; ++l) {
        const int pb = 1 + 5 * l;
        if (IN(pb) && l == 0) { p_norm(F, 0, 0); GRID_BAR(); }
        if (IN(pb + 1)) {
            const KP P = kparams(); F.refresh(P);
            pg8::Gemm g; g.A0 = g.A1 = (const bf16_t*)(F.ws + WS_H); g.B0 = g.B1 = (const bf16_t*)(F.ws + WS_W1 + l * W1_L); g.K = DM;
            pg8::StaticOrder S; S.init(MROWS / 256, N1 / 256, F.G, F.bid, DM / 64);
            Epi1 E{F.ws};
            pg8::gemm_phase<Epi1, pg8::StaticOrder, true, true>(F.lds, g, S, E);
            { constexpr int NU = (MROWS / 256) * (N1 / 256); const int full = NU % F.G;
              if (l + 1 < DEPTH && (full == 0 || F.bid >= full)) p_weights(F, l + 1, full ? F.bid - full : F.bid, full ? F.G - full : F.G, 1); }
            GRID_BAR();
        }
        if (IN(pb + 2)) {
            p_kfin(F, l);
            const KP P = kparams(); F.refresh(P);
            pg8::Gemm g; g.A0 = (const bf16_t*)(F.ws + WS_CQ); g.A1 = (const bf16_t*)(F.ws + WS_CKV);
            g.B0 = (const bf16_t*)(F.ws + WS_W2A + l * W2A_L); g.B1 = (const bf16_t*)(F.ws + WS_W2B + l * W2B_L); g.K = 512;
            pg8::GroupOrder S{MROWS / 256, 6, 8, F.G, F.bid};
            Epi2 E{F.ws, l};
            pg8::gemm_phase<Epi2, pg8::GroupOrder, true, true>(F.lds, g, S, E);
            GRID_BAR();
        }
        if (IN(pb + 3)) { p_attn(F, l);
            if (l + 1 < DEPTH && F.G > 64 && F.bid >= 64) { __syncthreads(); p_weights(F, l + 1, F.bid - 64, F.G - 64, 2); p_mod(F, l + 1, F.bid - 64, F.G - 64); }
            GRID_BAR(); }
        if (IN(pb + 4)) {
            const KP P = kparams(); F.refresh(P);
            pg8::Gemm g; g.A0 = g.A1 = (const bf16_t*)(F.ws + WS_Y); g.B0 = g.B1 = (const bf16_t*)(F.ws + WS_W3 + l * W3_L); g.K = DM;
            pg8::G3Order S{F.G, F.bid, l < DEPTH - 1 ? 1 : 0};
            const bool lastl = l == DEPTH - 1;
            Epi3 E{F.ws, F.lds, l};
            pg8::gemm_phase<Epi3, pg8::G3Order, true, true>(F.lds, g, S, E);
            if (!lastl) { p_norm(F, l + 1, NLAT); GRID_BAR(); }
        }
    }

#undef IN
}

extern "C" void kernel_launch(void* const* d_in, const int* in_sizes, int n_in, void* d_out, int out_size, void* d_ws, size_t ws_size, hipStream_t stream) {
    static int grid = 0;
    if (grid == 0) {
        if (n_in != 16 || out_size != NLAT * DM || ws_size < WS_END) { fprintf(stderr, "kernel_launch: unexpected shapes: n_in %d out %d ws %zu (need %zu)\n", n_in, out_size, ws_size, (size_t)WS_END); grid = -1; return; }
        int dev = 0, cus = 0, per_cu = 0;
        if (hipGetDevice(&dev) != hipSuccess || hipDeviceGetAttribute(&cus, hipDeviceAttributeMultiprocessorCount, dev) != hipSuccess) { grid = -1; return; }
        if (hipFuncSetAttribute((const void*)fwd_kernel, hipFuncAttributeMaxDynamicSharedMemorySize, LDS_BYTES) != hipSuccess) { fprintf(stderr, "kernel_launch: hipFuncSetAttribute failed\n"); grid = -1; return; }
        if (hipOccupancyMaxActiveBlocksPerMultiprocessor(&per_cu, (const void*)fwd_kernel, NTHREADS, LDS_BYTES) != hipSuccess || per_cu < 1) { fprintf(stderr, "kernel_launch: occupancy query says %d blocks per CU\n", per_cu); (void)hipGetLastError(); grid = -1; return; }
        grid = cus * 1;
    }
    if (grid < 0) return;
    Params p{};
    p.x = (const float*)d_in[0]; p.c = (const float*)d_in[1]; p.ctx = (const float*)d_in[2]; p.c_ctx = (const float*)d_in[3];
    p.w_ada = (const float*)d_in[4]; p.b_ada = (const float*)d_in[5]; p.norm_g = (const float*)d_in[6]; p.w_in = (const float*)d_in[7];
    p.q_gain = (const float*)d_in[8]; p.k_gain = (const float*)d_in[9]; p.cq_gain = (const float*)d_in[10]; p.ckv_gain = (const float*)d_in[11];
    p.w_uq = (const float*)d_in[12]; p.w_ukv = (const float*)d_in[13]; p.w_out = (const float*)d_in[14]; p.final_g = (const float*)d_in[15];
    p.out = (float*)d_out; p.ws = (unsigned char*)d_ws;
#if MK_ONE_LAUNCH
    if (hipMemsetAsync((char*)d_ws + WS_CTL, 0, 65536, stream) != hipSuccess) { fprintf(stderr, "kernel_launch: memset failed\n"); return; }
    p.ph_lo = 0; p.ph_hi = N_PHASES;
    void* args[] = {&p};
    hipError_t e = hipLaunchCooperativeKernel((const void*)fwd_kernel, dim3(grid), dim3(NTHREADS), args, LDS_BYTES, stream);
    if (e != hipSuccess) fprintf(stderr, "kernel_launch: cooperative launch failed: %s (grid %d)\n", hipGetErrorString(e), grid);
#else
    for (int ph = 0; ph < N_PHASES; ++ph) {
        p.ph_lo = ph; p.ph_hi = ph + 1;
        hipLaunchKernelGGL(fwd_kernel, dim3(grid), dim3(NTHREADS), LDS_BYTES, stream, p);
    }
    const hipError_t le = hipPeekAtLastError();
    if (le != hipSuccess) fprintf(stderr, "kernel_launch: launch failed: %s\n", hipGetErrorName(le));
#endif
}
```

```cpp
#include <hip/hip_runtime.h>
#include <hip/hip_cooperative_groups.h>
#include <cstdio>
#include <cstdint>
namespace cg = cooperative_groups;

#ifndef MK_ONE_LAUNCH
#define MK_ONE_LAUNCH 1
#endif

constexpr int DM = 2048, NB = 4, SEQ = 2048, DEPTH = 4, CTXL = 256;
constexpr int NLAT = NB * SEQ, NCTX = NB * CTXL, MROWS = NLAT + NCTX;
constexpr int NKEY = CTXL + SEQ;
constexpr int D_IN = 4672, N1 = 4864;
constexpr int NMOD = 3 * DM;
constexpr float EPS = 1e-6f;
constexpr int NWAVES = 8, NTHREADS = 512;

#define GAS __attribute__((address_space(1)))
#define LAS __attribute__((address_space(3)))
typedef unsigned short bf16_t;
typedef short bf16x8 __attribute__((ext_vector_type(8)));
typedef short s16x4 __attribute__((ext_vector_type(4)));
typedef float f32x2 __attribute__((ext_vector_type(2)));
typedef float f32x4 __attribute__((ext_vector_type(4)));
typedef float f32x16 __attribute__((ext_vector_type(16)));
typedef unsigned u32x2 __attribute__((ext_vector_type(2)));
typedef unsigned u32x4 __attribute__((ext_vector_type(4)));

constexpr size_t al256(size_t x) { return (x + 255) / 256 * 256; }
constexpr size_t WS_CTL = 0, CTL_BYTES = 1u << 20;
constexpr size_t WS_MOD = WS_CTL + CTL_BYTES;
constexpr size_t WS_ROPEG = WS_MOD + al256((size_t)DEPTH * 5 * NMOD * 4);
constexpr size_t WS_ROPEM = WS_ROPEG + (size_t)SEQ * 64 * 8;
constexpr size_t WS_W1 = WS_ROPEM + (size_t)SEQ * 32 * 8;
constexpr size_t W1_L = (size_t)N1 * DM * 2;
constexpr size_t WS_W2A = WS_W1 + DEPTH * W1_L;
constexpr size_t W2A_L = (size_t)1536 * 512 * 2;
constexpr size_t WS_W2B = WS_W2A + DEPTH * W2A_L;
constexpr size_t W2B_L = (size_t)2048 * 512 * 2;
constexpr size_t WS_W3 = WS_W2B + DEPTH * W2B_L;
constexpr size_t W3_L = (size_t)DM * DM * 2;
constexpr size_t WS_H = WS_W3 + DEPTH * W3_L;
constexpr size_t WS_QG = WS_H + (size_t)MROWS * DM * 2;
constexpr size_t WS_QGF = WS_QG + (size_t)MROWS * 1024 * 2;
constexpr size_t WS_KG = WS_QGF + (size_t)MROWS * 1024 * 2;
constexpr size_t WS_KGF = WS_KG + (size_t)MROWS * 256 * 2;
constexpr size_t WS_VG = WS_KGF + (size_t)MROWS * 256 * 2;
constexpr size_t WS_GS = WS_VG + (size_t)MROWS * 256 * 2;
constexpr size_t WS_CQ = WS_GS + (size_t)MROWS * DM * 2;
constexpr size_t WS_CKV = WS_CQ + (size_t)MROWS * 512 * 2;
constexpr size_t WS_KR = WS_CKV + (size_t)MROWS * 512 * 2;
constexpr size_t WS_KRF = WS_KR + (size_t)MROWS * 64 * 2;
constexpr size_t WS_SSQ = WS_KRF + (size_t)MROWS * 64 * 2;
constexpr size_t WS_QMN = WS_SSQ + (size_t)MROWS * 16 * 4;
constexpr size_t WS_QMR = WS_QMN + (size_t)MROWS * 1024 * 2;
constexpr size_t WS_KMN = WS_QMR + (size_t)MROWS * 512 * 2;
constexpr size_t WS_VM = WS_KMN + (size_t)MROWS * 1024 * 2;
constexpr size_t WS_Y = WS_VM + (size_t)MROWS * 1024 * 2;
constexpr size_t WS_XC = WS_Y + (size_t)MROWS * DM * 2;
constexpr size_t WS_SLAB = WS_XC + (size_t)NCTX * DM * 4;
constexpr size_t WS_XH = WS_SLAB + (size_t)8 * NCTX * DM * 4;
constexpr size_t WS_XL = WS_XH + (size_t)NLAT * DM * 2;
constexpr size_t WS_SSQX = WS_XL + (size_t)NLAT * DM;
constexpr size_t WS_END = WS_SSQX + (size_t)NLAT * 8 * 4;

constexpr int CW_BAR = 4096;
constexpr size_t CTL_KMAX = 32768;
constexpr size_t CTL_KRMAX = 32768 + 4 * 4 * 8 * 4 * 2 * 16 * 4;

constexpr int RING_BYTES = 131072;
constexpr int LDSCTL_OFF = 163840 - 512, MISC_OFF = LDSCTL_OFF + 320;
constexpr int LDS_BYTES = 163840;

struct Params {
    const float *x, *c, *ctx, *c_ctx, *w_ada, *b_ada, *norm_g, *w_in, *q_gain, *k_gain, *cq_gain, *ckv_gain, *w_uq, *w_ukv, *w_out, *final_g;
    float* out; unsigned char* ws;
    int ph_lo, ph_hi;
};
typedef const __attribute__((address_space(4))) Params* KP;
__device__ __forceinline__ KP kparams() { KP p = (KP)__builtin_amdgcn_kernarg_segment_ptr(); asm volatile("" : "+s"(p)); return p; }

#define LDS_WAIT() asm volatile("s_waitcnt lgkmcnt(0)" ::: "memory")
#define VM_WAIT() asm volatile("s_waitcnt vmcnt(0)" ::: "memory")
#define SBAR() __builtin_amdgcn_sched_barrier(0)
__device__ __forceinline__ unsigned cvt_pk_bf16(float lo, float hi) { unsigned r; asm volatile("v_cvt_pk_bf16_f32 %0, %1, %2" : "=v"(r) : "v"(lo), "v"(hi)); return r; }
__device__ __forceinline__ float bf2f(unsigned short h) { return __uint_as_float((unsigned)h << 16); }
__device__ __forceinline__ float bflo(unsigned w) { return __uint_as_float(w << 16); }
__device__ __forceinline__ float bfhi(unsigned w) { return __uint_as_float(w & 0xffff0000u); }
__device__ __forceinline__ float silu_f(float v) { return v * __builtin_amdgcn_rcpf(1.0f + __builtin_amdgcn_exp2f(-1.4426950408889634f * v)); }
__device__ __forceinline__ float wave_sum(float v) {
#pragma unroll
    for (int o = 1; o < 64; o <<= 1) v += __shfl_xor(v, o);
    return v;
}
__device__ __forceinline__ int opaque_tid() { int t = threadIdx.x; asm volatile("" : "+v"(t)); return t; }
__device__ __forceinline__ int kvrow_of(int r) { if (r < NLAT) { const int b = r >> 11; return b * NKEY + CTXL + (r & 2047); } const int rr = r - NLAT; return (rr >> 8) * NKEY + (rr & 255); }

namespace pg8 {
constexpr int BM = 256, BK = 64, HALF = 128, HTB = HALF * BK * 2, STAGE_BYTES = 8 * HTB, NXCD = 8, WGM = 8;
__host__ __device__ __forceinline__ int lds_byte(int r, int c) { const int st = (r >> 4) * 2 + (c >> 5), rr = r & 15, cc = c & 31, ob = rr * 64 + cc * 2; return st * 1024 + (ob ^ (((ob >> 9) & 1) << 5)); }
__host__ __device__ __forceinline__ void stage_rc(int b, int& R, int& C) { const int st = b / 1024, sb = b % 1024, swz = sb ^ (((sb >> 9) & 1) << 5); R = (st >> 1) * 16 + swz / 64; C = (st & 1) * 32 + (swz % 64) / 2; }
__host__ __device__ __forceinline__ int perm32(int rho) { const int n = rho >> 4, i = rho & 15; return 8 * (i >> 2) + 4 * n + (i & 3); }

struct Unit { int pm, pn, g, k0, nt; };
struct Gemm { const bf16_t *A0, *A1, *B0, *B1; int K;
    __device__ __forceinline__ const char* a(int g) const { return (const char*)(g ? A1 : A0); }
    __device__ __forceinline__ const char* b(int g) const { return (const char*)(g ? B1 : B0); } };

struct StaticOrder {
    int nM, nN, nwg, G, c, nt;
    __device__ void init(int nM_, int nN_, int G_, int c_, int nt_) { nM = nM_; nN = nN_; nwg = nM * nN; G = G_; c = c_; nt = nt_; }
    __device__ bool next(int i, Unit& u) const {
        const long L = (long)i * G + c; if (L >= nwg) return false;
        int wgid = (int)L; { const int q = nwg / NXCD, r = nwg % NXCD, xcd = wgid % NXCD, off = wgid / NXCD; wgid = (xcd < r ? xcd * (q + 1) : r * (q + 1) + (xcd - r) * q) + off; }
        const int nig = WGM * nN, gid = wgid / nig, fm = gid * WGM, gsz = (nM - fm) < WGM ? (nM - fm) : WGM;
        u.pm = fm + ((wgid % nig) % gsz); u.pn = (wgid % nig) / gsz; u.g = 0; u.k0 = 0; u.nt = nt; return true;
    }
};
struct G3Order {
    int G, c, ctx;
    __device__ bool next(int i, Unit& u) const {
        int L = i * G + c;
        if (ctx && i < 2) L = (1 - i) * G + c;
        if (L < 256) { const int x = L & 7, j = L >> 3; u.pm = x * 4 + (j >> 3); u.pn = j & 7; u.g = 0; u.k0 = 0; u.nt = 32; return true; }
        if (!ctx || L >= 512) return false;
        const int r = L - 256, t = r >> 3; u.pm = 32 + (t >> 3); u.pn = t & 7; u.g = 1; u.k0 = (r & 7) * 256; u.nt = 4; return true;
    }
};
struct GroupOrder {
    int nM, nN0, nN1, G, c;
    __device__ bool next(int i, Unit& u) const {
        const int L = i * G + c; const int n0 = nM * nN0, n1 = nM * nN1; if (L >= n0 + n1) return false;
        if (L < n0) { u.g = 0; u.pm = L % nM; u.pn = L / nM; } else { const int r = L - n0; u.g = 1; u.pm = r % nM; u.pn = r / nM; }
        u.k0 = 0; u.nt = 8; return true;
    }
};

template <class Epi, class Sched, bool ALIGN_EPI, bool SP2>
__device__ __forceinline__ void gemm_phase(LAS unsigned char* lds, const Gemm g, const Sched& S, const Epi& E) {
    const int tid = opaque_tid(), wid = __builtin_amdgcn_readfirstlane(tid >> 6), lane = tid & 63, wr = wid >> 2, wc = wid & 3, fr = lane & 15, fq = lane >> 4;
    const int K = g.K;
    unsigned voffA[2], voffB[2];
#pragma unroll
    for (int i = 0; i < 2; ++i) { int R, C; stage_rc(tid * 16 + i * 8192, R, C); const int Rb = Epi::PERM ? ((R & ~31) + perm32(R & 31)) : R;
        voffA[i] = (unsigned)(R * K + C) * 2u; voffB[i] = (unsigned)(Rb * K + C) * 2u; }
    const size_t kstep = (size_t)(BK * 2);
    const size_t hstep = (size_t)HALF * K * 2;
    const size_t tstep = 2 * hstep;
    const unsigned ldsw = (unsigned)wid * 1024u;
    const int aoff = lds_byte(wr * 64 + fr, fq * 8), boff = lds_byte(wc * 32 + fr, fq * 8);
#define PG8_SA(b, h) (((b) * 2 + (h)) * HTB)
#define PG8_SB(b, h) ((4 + (b) * 2 + (h)) * HTB)
#define PG8_STAGE(bufoff, gbase, voff) do { _Pragma("unroll") for (int _i = 0; _i < 2; ++_i) \
        __builtin_amdgcn_global_load_lds((const unsigned*)((const char*)(gbase) + (voff)[_i]), (LAS unsigned*)(lds + (bufoff) + ldsw + _i * 8192), 16, 0, 0); } while (0)
#define PG8_LDA(dst, b, h) do { _Pragma("unroll") for (int m = 0; m < 4; ++m) _Pragma("unroll") for (int k = 0; k < 2; ++k) dst[m][k] = *(const LAS bf16x8*)(lds + PG8_SA(b, h) + aoff + m * 2048 + k * 1024); } while (0)
#define PG8_LDB(dst, b, h) do { _Pragma("unroll") for (int n = 0; n < 2; ++n) _Pragma("unroll") for (int k = 0; k < 2; ++k) dst[n][k] = *(const LAS bf16x8*)(lds + PG8_SB(b, h) + boff + n * 2048 + k * 1024); } while (0)
#define PG8_MMA(ai, bj, At, Bt) do { __builtin_amdgcn_s_setprio(1); _Pragma("unroll") for (int m = 0; m < 4; ++m) _Pragma("unroll") for (int n = 0; n < 2; ++n) _Pragma("unroll") for (int k = 0; k < 2; ++k) \
        acc[ai][bj][m][n] = __builtin_amdgcn_mfma_f32_16x16x32_bf16(Bt[n][k], At[m][k], acc[ai][bj][m][n], 0, 0, 0); __builtin_amdgcn_s_setprio(0); } while (0)
#define PG8_WAIT_V(n) asm volatile("s_waitcnt vmcnt(" #n ")" ::: "memory")
#define PG8_WAIT_L(n) asm volatile("s_waitcnt lgkmcnt(" #n ")" ::: "memory")
#define PG8_BAR __builtin_amdgcn_s_barrier()
#define PG8_SCHED __builtin_amdgcn_sched_barrier(0)
    Unit cur, nxt; int ui = 0;
    if (!S.next(0, cur)) return;
    f32x4 acc[2][2][4][2];
#pragma unroll
    for (int a = 0; a < 2; ++a)
#pragma unroll
        for (int b = 0; b < 2; ++b)
#pragma unroll
            for (int m = 0; m < 4; ++m)
#pragma unroll
                for (int n = 0; n < 2; ++n) acc[a][b][m][n] = (f32x4){0.f, 0.f, 0.f, 0.f};
    bf16x8 At[4][2], B0[2][2], B1[2][2];
    const char* cA = g.a(cur.g) + (size_t)cur.pm * tstep + (size_t)cur.k0 * 2; const char* cB = g.b(cur.g) + (size_t)cur.pn * tstep + (size_t)cur.k0 * 2;
    if constexpr (SP2) {
        PG8_STAGE(PG8_SB(0, 0), cB, voffB); PG8_STAGE(PG8_SB(0, 1), cB + hstep, voffB); PG8_STAGE(PG8_SA(0, 0), cA, voffA); PG8_STAGE(PG8_SA(0, 1), cA + hstep, voffA);
        if (wr == 1) PG8_BAR;
        PG8_WAIT_V(2); PG8_BAR;
        PG8_STAGE(PG8_SB(1, 0), cB + kstep, voffB); PG8_STAGE(PG8_SA(1, 0), cA + kstep, voffA); PG8_STAGE(PG8_SB(1, 1), cB + hstep + kstep, voffB);
        PG8_WAIT_V(6); PG8_BAR;
    } else {
        PG8_STAGE(PG8_SB(0, 0), cB, voffB); PG8_STAGE(PG8_SA(0, 0), cA, voffA); PG8_STAGE(PG8_SB(0, 1), cB + hstep, voffB); PG8_STAGE(PG8_SA(0, 1), cA + hstep, voffA);
        if (wr == 1) PG8_BAR;
        PG8_WAIT_V(4); PG8_BAR;
        PG8_STAGE(PG8_SB(1, 0), cB + kstep, voffB); PG8_STAGE(PG8_SA(1, 0), cA + kstep, voffA); PG8_STAGE(PG8_SB(1, 1), cB + hstep + kstep, voffB);
        PG8_WAIT_V(6); PG8_BAR;
    }
    for (;;) {
        const bool has_next = S.next(ui + 1, nxt);
        const char* nA = has_next ? g.a(nxt.g) + (size_t)nxt.pm * tstep + (size_t)nxt.k0 * 2 : cA; const char* nB = has_next ? g.b(nxt.g) + (size_t)nxt.pn * tstep + (size_t)nxt.k0 * 2 : cB;
        const int nt = cur.nt;
        for (int t = 0; t < nt; t += 2) {
            const bool last = (t == nt - 2);
            const char* a1 = cA + (size_t)(t + 1) * kstep;
            const char* a2 = last ? nA : cA + (size_t)(t + 2) * kstep; const char* b2 = last ? nB : cB + (size_t)(t + 2) * kstep;
            const char* a3 = a2 + kstep; const char* b3 = b2 + kstep;
            if constexpr (SP2) {
            PG8_LDB(B0, 0, 0); PG8_LDB(B1, 0, 1); PG8_SCHED; PG8_LDA(At, 0, 0); PG8_STAGE(PG8_SA(1, 1), a1 + hstep, voffA);
            PG8_WAIT_V(8); PG8_WAIT_L(0); PG8_BAR; PG8_MMA(0, 0, At, B0); PG8_MMA(0, 1, At, B1); PG8_BAR; PG8_SCHED;
            PG8_LDA(At, 0, 1); PG8_STAGE(PG8_SB(0, 0), b2, voffB); PG8_STAGE(PG8_SB(0, 1), b2 + hstep, voffB); PG8_STAGE(PG8_SA(0, 0), a2, voffA);
            PG8_WAIT_V(8); PG8_WAIT_L(0); PG8_BAR; PG8_MMA(1, 0, At, B0); PG8_MMA(1, 1, At, B1); PG8_BAR; PG8_SCHED;
            PG8_LDB(B0, 1, 0); PG8_LDB(B1, 1, 1); PG8_SCHED; PG8_LDA(At, 1, 0); PG8_STAGE(PG8_SA(0, 1), a2 + hstep, voffA);
            PG8_WAIT_V(8); PG8_WAIT_L(0); PG8_BAR; PG8_MMA(0, 0, At, B0); PG8_MMA(0, 1, At, B1); PG8_BAR; PG8_SCHED;
            PG8_LDA(At, 1, 1); PG8_STAGE(PG8_SB(1, 0), b3, voffB); PG8_STAGE(PG8_SB(1, 1), b3 + hstep, voffB); PG8_STAGE(PG8_SA(1, 0), a3, voffA);
            PG8_WAIT_V(8); PG8_WAIT_L(0); PG8_BAR; PG8_MMA(1, 0, At, B0); PG8_MMA(1, 1, At, B1); PG8_BAR; PG8_SCHED;
            } else {
            PG8_LDB(B0, 0, 0); PG8_SCHED; PG8_LDA(At, 0, 0); PG8_STAGE(PG8_SA(1, 1), a1 + hstep, voffA);
            PG8_WAIT_L(8); PG8_BAR; PG8_WAIT_L(0); PG8_MMA(0, 0, At, B0); PG8_BAR; PG8_SCHED;
            PG8_LDB(B1, 0, 1); PG8_STAGE(PG8_SB(0, 0), b2, voffB);
            PG8_BAR; PG8_WAIT_L(0); PG8_MMA(0, 1, At, B1); PG8_BAR;
            PG8_LDA(At, 0, 1); PG8_STAGE(PG8_SA(0, 0), a2, voffA);
            PG8_BAR; PG8_WAIT_L(0); PG8_MMA(1, 0, At, B0); PG8_BAR; PG8_SCHED;
            PG8_STAGE(PG8_SB(0, 1), b2 + hstep, voffB);
            PG8_WAIT_V(6); PG8_BAR; PG8_MMA(1, 1, At, B1); PG8_BAR;
            PG8_LDB(B0, 1, 0); PG8_SCHED; PG8_LDA(At, 1, 0); PG8_STAGE(PG8_SA(0, 1), a2 + hstep, voffA);
            PG8_WAIT_L(8); PG8_BAR; PG8_WAIT_L(0); PG8_MMA(0, 0, At, B0); PG8_BAR; PG8_SCHED;
            PG8_LDB(B1, 1, 1); PG8_STAGE(PG8_SB(1, 0), b3, voffB);
            PG8_BAR; PG8_WAIT_L(0); PG8_MMA(0, 1, At, B1); PG8_BAR;
            PG8_LDA(At, 1, 1); PG8_STAGE(PG8_SA(1, 0), a3, voffA);
            PG8_BAR; PG8_WAIT_L(0); PG8_MMA(1, 0, At, B0); PG8_BAR; PG8_SCHED;
            PG8_STAGE(PG8_SB(1, 1), b3 + hstep, voffB);
            PG8_WAIT_V(6); PG8_BAR; PG8_MMA(1, 1, At, B1); PG8_BAR;
            }
        }
        if constexpr (ALIGN_EPI) { if (wr == 0) PG8_BAR; }
        if constexpr (Epi::AFTER_DRAIN) { if (has_next) E(acc, cur, wr, wc, fr, fq); }
        else E(acc, cur, wr, wc, fr, fq);
        if (!has_next) break;
#pragma unroll
        for (int a = 0; a < 2; ++a)
#pragma unroll
            for (int b = 0; b < 2; ++b)
#pragma unroll
                for (int m = 0; m < 4; ++m)
#pragma unroll
                    for (int n = 0; n < 2; ++n) acc[a][b][m][n] = (f32x4){0.f, 0.f, 0.f, 0.f};
        cur = nxt; cA = nA; cB = nB; ++ui;
        if constexpr (ALIGN_EPI) { if (wr == 1) PG8_BAR; }
    }
    PG8_WAIT_V(0);
    if constexpr (!ALIGN_EPI) { if (wr == 0) PG8_BAR; }
    PG8_BAR;
    if constexpr (Epi::AFTER_DRAIN) E.fused(acc, cur, wr, wc, fr, fq);
#undef PG8_SA
#undef PG8_SB
#undef PG8_STAGE
#undef PG8_LDA
#undef PG8_LDB
#undef PG8_MMA
#undef PG8_WAIT_V
#undef PG8_WAIT_L
#undef PG8_BAR
#undef PG8_SCHED
}
}

#define XB_TMO      128
#define XB_XCNT(j)  (256  + 64 * (j))
#define XB_XSUB(j)  (1280 + 64 * (j))
#define XB_XGEN(j)  (2304 + 64 * (j))
#define XB_TOP      3328
#define XB_TOPGEN   3392
#define XCD_BAR_WORDS 3456
#define XB_SPIN_CAP (1u << 18)
__device__ __forceinline__ unsigned xb_ld(unsigned* p)              { return __hip_atomic_load(p, __ATOMIC_RELAXED, __HIP_MEMORY_SCOPE_AGENT); }
__device__ __forceinline__ unsigned xb_add(unsigned* p, unsigned v) { return __hip_atomic_fetch_add(p, v, __ATOMIC_RELAXED, __HIP_MEMORY_SCOPE_AGENT); }
__device__ __forceinline__ unsigned xb_xcc_id() { return (unsigned)__builtin_amdgcn_s_getreg((3 << 11) | 20) & 0xFu; }
#define XB_SPIN(cond, bar) do { unsigned _sp = 0; while (cond) { __builtin_amdgcn_s_sleep(1); \
    if ((++_sp & 255u) == 0u) { if (xb_ld(&(bar)[XB_TMO])) break; if (_sp > XB_SPIN_CAP) { atomicAdd(&(bar)[XB_TMO], 1u); break; } } } } while (0)
struct XcdBarrier { unsigned* bar; unsigned x; volatile LAS unsigned* st; };
__device__ __forceinline__ XcdBarrier xcd_barrier_post(unsigned* bar, volatile LAS unsigned* st) {
    XcdBarrier b; b.bar = bar; b.x = xb_xcc_id(); b.st = st;
    if (threadIdx.x == 0) (void)xb_add(&bar[XB_XCNT(b.x)], 1u);
    return b;
}
__device__ __forceinline__ void xcd_barrier_complete(unsigned* bar, unsigned x, unsigned& nloc, unsigned& nx) {
    const unsigned G = gridDim.x * gridDim.y * gridDim.z;
    unsigned sum, cnt, mine, sp = 0u;
    for (;;) {
        sum = 0u; cnt = 0u; mine = 0u;
#pragma unroll
        for (unsigned j = 0; j < 16; ++j) { const unsigned c = xb_ld(&bar[XB_XCNT(j)]); sum += c; cnt += (c > 0u) ? 1u : 0u; mine = (j == x) ? c : mine; }
        if (sum == G) break;
        __builtin_amdgcn_s_sleep(1);
        if ((++sp & 255u) == 0u) { if (xb_ld(&bar[XB_TMO])) break; if (sp > XB_SPIN_CAP) { atomicAdd(&bar[XB_TMO], 1u); break; } }
    }
    nloc = mine > 0u ? mine : 1u; nx = cnt > 0u ? cnt : 1u;
}
__device__ __forceinline__ void xcd_barrier(const XcdBarrier& b) {
    asm volatile("s_waitcnt vmcnt(0)" ::: "memory");
    __syncthreads();
    if (threadIdx.x == 0) {
        unsigned* bar = b.bar;
        __builtin_amdgcn_s_waitcnt(0);
        unsigned nloc = b.st[0], nx = b.st[1];
        if (nloc == 0u) { xcd_barrier_complete(bar, b.x, nloc, nx); b.st[0] = nloc; b.st[1] = nx; }
        const unsigned old = xb_add(&bar[XB_XSUB(b.x)], 1u);
        const unsigned gen = old / nloc;
        if (old + 1u == (gen + 1u) * nloc) {
            __builtin_amdgcn_fence(__ATOMIC_RELEASE, "agent");
            asm volatile("s_waitcnt vmcnt(0)" ::: "memory");
            const unsigned og = xb_add(&bar[XB_TOP], 1u);
            const unsigned tg = og / nx;
            if (og + 1u == (tg + 1u) * nx) xb_add(&bar[XB_TOPGEN], 1u);
            else XB_SPIN(xb_ld(&bar[XB_TOPGEN]) == tg, bar);
            __builtin_amdgcn_fence(__ATOMIC_ACQUIRE, "agent");
            xb_add(&bar[XB_XGEN(b.x)], 1u);
            asm volatile("s_waitcnt vmcnt(0)" ::: "memory");
        } else {
            XB_SPIN(xb_ld(&bar[XB_XGEN(b.x)]) == gen, bar);
            __builtin_amdgcn_fence(__ATOMIC_ACQUIRE, "agent");
            asm volatile("s_waitcnt vmcnt(0)" ::: "memory");
        }
    }
    __syncthreads();
}

__device__ __forceinline__ u32x4 pack8(f32x4 a, f32x4 b) { u32x4 w; w.x = cvt_pk_bf16(a[0], a[1]); w.y = cvt_pk_bf16(a[2], a[3]); w.z = cvt_pk_bf16(b[0], b[1]); w.w = cvt_pk_bf16(b[2], b[3]); return w; }

typedef _Float16 h16x2_t __attribute__((ext_vector_type(2)));
__device__ __forceinline__ unsigned cvt_pk_h16(float a, float b) { const f32x2 v = {a, b}; const h16x2_t h = __builtin_convertvector(v, h16x2_t); return *reinterpret_cast<const unsigned*>(&h); }
__device__ __forceinline__ f32x2 up_h16(unsigned w) { const h16x2_t h = *reinterpret_cast<const h16x2_t*>(&w); return __builtin_convertvector(h, f32x2); }
__device__ __forceinline__ void xenc8(const f32x4 a, const f32x4 b, u32x4& hi) {
    hi.x = cvt_pk_h16(a[0], a[1]); hi.y = cvt_pk_h16(a[2], a[3]); hi.z = cvt_pk_h16(b[0], b[1]); hi.w = cvt_pk_h16(b[2], b[3]);
}
__device__ __forceinline__ void xdec8(const u32x4 hi, f32x4& a, f32x4& b) {
    const f32x2 d0 = up_h16(hi.x), d1 = up_h16(hi.y), d2 = up_h16(hi.z), d3 = up_h16(hi.w);
    a[0] = d0.x; a[1] = d0.y; a[2] = d1.x; a[3] = d1.y; b[0] = d2.x; b[1] = d2.y; b[2] = d3.x; b[3] = d3.y;
}

__device__ __forceinline__ size_t qblk_off(int r, int head, int c, int NC) { return ((((size_t)(r >> 5) * 8 + head) * NC + c) * 32 + (r & 31)) * 8; }
struct Epi1 {
    static constexpr bool PERM = true, AFTER_DRAIN = false;
    unsigned char* ws;
    __device__ __forceinline__ void operator()(f32x4 (&acc)[2][2][4][2], const pg8::Unit& u, int wr, int wc, int fr, int fq) const {
        const int pn = u.pn, pm = u.pm;
        const int row0 = pm * 256 + wr * 64 + fr;
        const int lc = wc * 32 + 8 * fq;
        bf16_t* base; int ld, coff; int mode = 0, ssq0 = 0; int rdelta = 0;
        float* SSQ = (float*)(ws + WS_SSQ);
        if (pn < 4) { base = (bf16_t*)(ws + WS_QG); ld = 1024; coff = 256 * pn; }
        else if (pn == 4) { base = (bf16_t*)(ws + WS_KG); ld = 256; coff = 0; }
        else if (pn == 5) { base = (bf16_t*)(ws + WS_VG); ld = 256; coff = 0; rdelta = (pm < 32) ? ((pm >> 3) * 256 + 256) : ((pm - 32) * 2048 - NLAT); }
        else if (pn < 10) { base = (bf16_t*)(ws + WS_GS); ld = 2048; coff = 256 * (pn - 6); mode = 1; }
        else if (pn < 12) { base = (bf16_t*)(ws + WS_CQ); ld = 512; coff = 256 * (pn - 10); mode = 2; ssq0 = (pn - 10) * 4; }
        else if (pn < 14) { base = (bf16_t*)(ws + WS_CKV); ld = 512; coff = 256 * (pn - 12); mode = 2; ssq0 = 8 + (pn - 12) * 4; }
        else if (pn < 18) { base = (bf16_t*)(ws + WS_GS); ld = 2048; coff = 1024 + 256 * (pn - 14); mode = 1; }
        else { base = (bf16_t*)(ws + WS_KR); ld = 64; coff = 0; mode = 3; }
#pragma unroll
        for (int ai = 0; ai < 2; ++ai)
#pragma unroll
            for (int m = 0; m < 4; ++m) {
                const int r = row0 + ai * 128 + m * 16;
                bf16_t* rowp = base + (size_t)(r + rdelta) * ld + coff + lc;
                if (mode == 1) {
#pragma unroll
                    for (int bj = 0; bj < 2; ++bj) { f32x4 v0 = acc[ai][bj][m][0], v1 = acc[ai][bj][m][1];
#pragma unroll
                        for (int j = 0; j < 4; ++j) { v0[j] = silu_f(v0[j]); v1[j] = silu_f(v1[j]); }
                        *(u32x4*)(rowp + bj * 128) = pack8(v0, v1); }
                } else if (mode == 3) {
                    if (wc < 2) *(u32x4*)(rowp) = pack8(acc[ai][0][m][0], acc[ai][0][m][1]);
                } else {
                    float s = 0.f;
#pragma unroll
                    for (int bj = 0; bj < 2; ++bj) { const f32x4 v0 = acc[ai][bj][m][0], v1 = acc[ai][bj][m][1];
                        if (mode == 2) s += (v0[0] * v0[0] + v0[1] * v0[1]) + (v0[2] * v0[2] + v0[3] * v0[3]) + (v1[0] * v1[0] + v1[1] * v1[1]) + (v1[2] * v1[2] + v1[3] * v1[3]);
                        bf16_t* d_ = pn < 4 ? base + qblk_off(r, 2 * pn + bj, lc >> 3, 16) : rowp + bj * 128;
                        *(u32x4*)(d_) = pack8(v0, v1); }
                    if (mode == 2) { s += __shfl_xor(s, 16); s += __shfl_xor(s, 32); if (fq == 0) SSQ[(size_t)r * 16 + ssq0 + wc] = s; }
                }
            }
    }
};

struct Epi2 {
    static constexpr bool PERM = true, AFTER_DRAIN = false;
    unsigned char* ws; int l;
    __device__ __forceinline__ void operator()(f32x4 (&acc)[2][2][4][2], const pg8::Unit& u, int wr, int wc, int fr, int fq) const {
        const int pn = u.pn, pm = u.pm, g = u.g;
        const int row0 = pm * 256 + wr * 64 + fr;
        const int lc = wc * 32 + 8 * fq;
        const int rdelta = (pm < 32) ? ((pm >> 3) * 256 + 256) : ((pm - 32) * 2048 - NLAT);
        bf16_t* QMN = (bf16_t*)(ws + WS_QMN); bf16_t* QMR = (bf16_t*)(ws + WS_QMR); bf16_t* KMN = (bf16_t*)(ws + WS_KMN); bf16_t* VM = (bf16_t*)(ws + WS_VM);
        const float* SSQ = (const float*)(ws + WS_SSQ); const f32x2* ropeM = (const f32x2*)(ws + WS_ROPEM);
        float kmx = 0.f;
        f32x4 n0, n1; { const f32x4* sp = (const f32x4*)(SSQ + (size_t)row0 * 16 + g * 8); n0 = sp[0]; n1 = sp[1]; }
#pragma unroll
        for (int ai = 0; ai < 2; ++ai)
#pragma unroll
            for (int m = 0; m < 4; ++m) {
                const int r = row0 + ai * 128 + m * 16;
                const f32x4 s0 = n0, s1 = n1;
                if (ai * 4 + m < 7) { const int rn = row0 + ((ai * 4 + m + 1) >> 2) * 128 + ((ai * 4 + m + 1) & 3) * 16; const f32x4* sp = (const f32x4*)(SSQ + (size_t)rn * 16 + g * 8); n0 = sp[0]; n1 = sp[1]; }
                const float ss = ((s0[0] + s0[1]) + (s0[2] + s0[3])) + ((s1[0] + s1[1]) + (s1[2] + s1[3]));
                const float rs = __builtin_amdgcn_rsqf(ss * (1.0f / 512.0f) + EPS) * (g == 0 ? 0.07216878364870323f * 1.4426950408889634f : 1.0f);
                f32x4 a0 = acc[ai][0][m][0] * rs, a1 = acc[ai][0][m][1] * rs, b0 = acc[ai][1][m][0] * rs, b1 = acc[ai][1][m][1] * rs;
                if (g == 0) {
                    if (pn < 4) {
                        *(u32x4*)(QMN + qblk_off(r, 2 * pn, lc >> 3, 16)) = pack8(a0, a1); *(u32x4*)(QMN + qblk_off(r, 2 * pn + 1, lc >> 3, 16)) = pack8(b0, b1);
                    } else {
                        const int head = 4 * (pn - 4) + wc, i0 = 8 * fq;
                        if (pm < 32) {
                            const f32x2* cs = ropeM + (size_t)(r & 2047) * 32 + i0;
#pragma unroll
                            for (int j = 0; j < 4; ++j) { const f32x2 t0 = cs[j], t1 = cs[4 + j];
                                const float x1 = a0[j], x2 = b0[j]; a0[j] = x1 * t0.x - x2 * t0.y; b0[j] = x2 * t0.x + x1 * t0.y;
                                const float y1 = a1[j], y2 = b1[j]; a1[j] = y1 * t1.x - y2 * t1.y; b1[j] = y2 * t1.x + y1 * t1.y; }
                        }
                        *(u32x4*)(QMR + qblk_off(r, head, fq, 8)) = pack8(a0, a1); *(u32x4*)(QMR + qblk_off(r, head, 4 + fq, 8)) = pack8(b0, b1);
                    }
                } else {
                    const size_t o = (size_t)(r + rdelta) * 1024 + pn * 128 + lc;
                    *(u32x4*)(KMN + o) = pack8(a0, a1); *(u32x4*)(VM + o) = pack8(b0, b1);
                    float s = ((a0[0] * a0[0] + a0[1] * a0[1]) + (a0[2] * a0[2] + a0[3] * a0[3])) + ((a1[0] * a1[0] + a1[1] * a1[1]) + (a1[2] * a1[2] + a1[3] * a1[3]));
                    s += __shfl_xor(s, 16); s += __shfl_xor(s, 32); kmx = fmaxf(kmx, s);
                }
                asm volatile("" ::: "memory");
            }
        if (g == 1) {
            kmx = fmaxf(kmx, __shfl_xor(kmx, 1)); kmx = fmaxf(kmx, __shfl_xor(kmx, 2)); kmx = fmaxf(kmx, __shfl_xor(kmx, 4)); kmx = fmaxf(kmx, __shfl_xor(kmx, 8));
            const int b = pm < 32 ? (pm >> 3) : (pm - 32);
            if ((fr | fq) == 0) ((float*)(ws + WS_CTL + CTL_KMAX))[((((l * 4 + b) * 8 + pn) * 4 + wc) * 2 + wr) * 16 + (pm < 32 ? (pm & 7) : 8)] = kmx;
        }
    }
};

struct Epi3 {
    static constexpr bool PERM = true, AFTER_DRAIN = true;
    unsigned char* ws; LAS unsigned char* lds; int l;
    __device__ __forceinline__ void operator()(f32x4 (&acc)[2][2][4][2], const pg8::Unit& u, int wr, int wc, int fr, int fq) const {
        const int pm = u.pm;
        const int col0 = u.pn * 256 + wc * 32 + 8 * fq;
        if (u.g == 1) {
            bf16_t* sl = (bf16_t*)(ws + WS_SLAB) + (size_t)(u.k0 >> 8) * NCTX * DM;
            const int row0 = (pm - 32) * 256 + wr * 64 + fr;
#pragma unroll
            for (int ai = 0; ai < 2; ++ai)
#pragma unroll
                for (int m = 0; m < 4; ++m) { const size_t off = (size_t)(row0 + ai * 128 + m * 16) * DM + col0;
#pragma unroll
                    for (int bj = 0; bj < 2; ++bj) *(u32x4*)(sl + off + bj * 128) = pack8(acc[ai][bj][m][0], acc[ai][bj][m][1]); }
        }
    }
    __device__ __forceinline__ void fused(f32x4 (&acc)[2][2][4][2], const pg8::Unit& u, int wr, int wc, int fr, int fq) const {
        const int pm = u.pm;
        const int col0 = u.pn * 256 + wc * 32 + 8 * fq;
        const int b5 = pm >> 3;
        const int row0 = pm * 256 + wr * 64 + fr;
        const KP P = kparams();
        const bool first = l == 0, last = l == DEPTH - 1;
        const float* x0 = P->x; bf16_t* XH = (bf16_t*)(ws + WS_XH); unsigned char* XL = ws + WS_XL; bf16_t* H = (bf16_t*)(ws + WS_H); float* outp = P->out; float* ssqx = (float*)(ws + WS_SSQX);
        const float* mod = (const float*)(ws + WS_MOD) + (size_t)l * 5 * NMOD; const float* modn = mod + (last ? 0 : 5 * NMOD);
        const float* gn = last ? P->final_g : P->norm_g + (l + 1) * DM;
        XcdBarrier bar; bar.bar = (unsigned*)(ws + WS_CTL) + CW_BAR; bar.x = xb_xcc_id(); bar.st = (volatile LAS unsigned*)(lds + MISC_OFF) + 8;
        LAS float* Pl = (LAS float*)(lds + RING_BYTES);
        {
            const float* gp = mod + b5 * NMOD + 2 * DM + col0;
#pragma unroll
            for (int ai = 0; ai < 2; ++ai)
#pragma unroll
                for (int m = 0; m < 4; ++m) { const size_t off = (size_t)(row0 + ai * 128 + m * 16) * DM + col0; float s = 0.f;
#pragma unroll
                    for (int bj = 0; bj < 2; ++bj) { f32x4 xa, xb;
                        if (first) { xa = *(const f32x4*)(x0 + off + bj * 128); xb = *(const f32x4*)(x0 + off + bj * 128 + 4); }
                        else xdec8(*(const u32x4*)(XH + off + bj * 128), xa, xb);
                        const f32x4 na = xa + *(const f32x4*)(gp + bj * 128) * acc[ai][bj][m][0], nb = xb + *(const f32x4*)(gp + bj * 128 + 4) * acc[ai][bj][m][1];
                        acc[ai][bj][m][0] = na; acc[ai][bj][m][1] = nb;
                        s += ((na[0] * na[0] + na[1] * na[1]) + (na[2] * na[2] + na[3] * na[3])) + ((nb[0] * nb[0] + nb[1] * nb[1]) + (nb[2] * nb[2] + nb[3] * nb[3])); }
                    asm volatile("" : "+v"(acc[ai][0][m][0]), "+v"(acc[ai][0][m][1]), "+v"(acc[ai][1][m][0]), "+v"(acc[ai][1][m][1]));
                    s += __shfl_xor(s, 16); s += __shfl_xor(s, 32);
                    Pl[fq == 0 ? (ai * 128 + wr * 64 + m * 16 + fr) * 4 + wc : 1024 + wc * 64 + fq * 16 + fr] = s;
                    asm volatile("" ::: "memory"); }
            asm volatile("s_waitcnt lgkmcnt(0)" ::: "memory"); __builtin_amdgcn_s_barrier(); asm volatile("" ::: "memory");
            const int tid = opaque_tid();
            if (tid < 256) { const LAS f32x4* p4 = (const LAS f32x4*)Pl + tid; const f32x4 q = *p4; ssqx[(size_t)(pm * 256 + tid) * 8 + u.pn] = (q[0] + q[1]) + (q[2] + q[3]); }
        }
        xcd_barrier(bar);
        {
            float rs[2][4];
#pragma unroll
            for (int ai = 0; ai < 2; ++ai)
#pragma unroll
                for (int m = 0; m < 4; ++m) { const int r = row0 + ai * 128 + m * 16;
                    const f32x4 s0 = *(const f32x4*)(ssqx + (size_t)r * 8), s1 = *(const f32x4*)(ssqx + (size_t)r * 8 + 4);
                    rs[ai][m] = rsqrtf((((s0[0] + s0[1]) + (s0[2] + s0[3])) + ((s1[0] + s1[1]) + (s1[2] + s1[3]))) * (1.0f / DM) + EPS); }
            if (last) {
#pragma unroll
                for (int bj = 0; bj < 2; ++bj) { const int c = col0 + bj * 128; const f32x4 ga = *(const f32x4*)(gn + c), gb = *(const f32x4*)(gn + c + 4);
#pragma unroll
                    for (int ai = 0; ai < 2; ++ai)
#pragma unroll
                        for (int m = 0; m < 4; ++m) { float* op = outp + (size_t)(row0 + ai * 128 + m * 16) * DM + c;
                            *(f32x4*)(op) = acc[ai][bj][m][0] * rs[ai][m] * ga; *(f32x4*)(op + 4) = acc[ai][bj][m][1] * rs[ai][m] * gb; }
                    asm volatile("" ::: "memory"); }
            } else {
#pragma unroll
                for (int bj = 0; bj < 2; ++bj) { const int c = col0 + bj * 128;
                    const f32x4 ga = *(const f32x4*)(gn + c) * (*(const f32x4*)(modn + b5 * NMOD + DM + c) + 1.0f), gb = *(const f32x4*)(gn + c + 4) * (*(const f32x4*)(modn + b5 * NMOD + DM + c + 4) + 1.0f);
                    const f32x4 sa = *(const f32x4*)(modn + b5 * NMOD + c), sb = *(const f32x4*)(modn + b5 * NMOD + c + 4);
#pragma unroll
                    for (int ai = 0; ai < 2; ++ai)
#pragma unroll
                        for (int m = 0; m < 4; ++m) { const size_t off = (size_t)(row0 + ai * 128 + m * 16) * DM + c; const f32x4 na = acc[ai][bj][m][0], nb = acc[ai][bj][m][1];
                            u32x4 hi; xenc8(na, nb, hi); *(u32x4*)(XH + off) = hi;
                            *(u32x4*)(H + off) = pack8(na * rs[ai][m] * ga + sa, nb * rs[ai][m] * gb + sb); }
                    asm volatile("" ::: "memory"); }
            }
        }
    }
};

namespace attn {
constexpr int QBLK = 32, KVBLK = 64;
constexpr size_t SHM_V = KVBLK * 128 * 2, SHM_K = KVBLK * 128 * 2, SHM_KR = KVBLK * 64 * 2;
constexpr int NST = 3;
constexpr size_t OFF_V = 0, OFF_K = NST * SHM_V, OFF_KR = OFF_K + NST * SHM_K, OFF_WS = OFF_KR + NST * SHM_KR, OFF_QR = OFF_WS + NWAVES * 64 * 4;
constexpr size_t OFF_OST = 0;
constexpr int OST_LD = 272;
constexpr size_t ATTN_LDS = OFF_QR + (size_t)NWAVES * 64 * 64;
static_assert((size_t)NWAVES * QBLK * OST_LD <= OFF_WS, "output staging must fit in the ring");
constexpr float THR = 8.f;
#define KSWZ(row, colB) ((row) * 256 + ((colB) ^ (((row) & 15) << 4)))
#define KRSWZ(row, colB) ((row) * 128 + ((colB) ^ ((((row) >> 1) & 7) << 4)))
__device__ __forceinline__ int crow(int r, int hi) { return (r & 3) + 8 * (r >> 2) + 4 * hi; }

template <bool MLA> struct Cfg { static constexpr float SCALE = MLA ? 0.07216878364870323f : 0.08838834764831845f; static constexpr int LDK = MLA ? 1024 : 256; };

__device__ __forceinline__ void partialSM_fixed(f32x16& p0, float off) {
#pragma unroll
    for (int r = 0; r < 16; ++r) p0[r] = __builtin_amdgcn_exp2f(p0[r]);
}
typedef __bf16 bf16x2_t __attribute__((ext_vector_type(2)));
__device__ __forceinline__ unsigned cvt_pk2(float lo, float hi) { const f32x2 v = {lo, hi}; const bf16x2_t b = __builtin_convertvector(v, bf16x2_t); return *reinterpret_cast<const unsigned*>(&b); }
template <bool FIXED>
__device__ __forceinline__ void finishSM(f32x16& p0, f32x16& p1, float alpha, float off, float& l_reg, bf16x8& pa0, bf16x8& pa1, bf16x8& pa2, bf16x8& pa3) {
#pragma unroll
    for (int r = 0; r < 16; ++r) p1[r] = __builtin_amdgcn_exp2f(p1[r]);
    float ps = 0;
#pragma unroll
    for (int r = 0; r < 16; ++r) ps += p0[r];
#pragma unroll
    for (int r = 0; r < 16; ++r) ps += p1[r];
    { auto rr = __builtin_amdgcn_permlane32_swap(__float_as_uint(ps), __float_as_uint(ps), false, false);
      ps = __uint_as_float(rr[0]) + __uint_as_float(rr[1]); }
    l_reg = FIXED ? l_reg + ps : l_reg * alpha + ps;
#define PK4(P, BASE, OUT) do { u32x4 w = {cvt_pk2(P[BASE + 0], P[BASE + 1]), cvt_pk2(P[BASE + 2], P[BASE + 3]), cvt_pk2(P[BASE + 4], P[BASE + 5]), cvt_pk2(P[BASE + 6], P[BASE + 7])};   \
    OUT = *reinterpret_cast<bf16x8*>(&w); } while (0)
    PK4(p0, 0, pa0); PK4(p0, 8, pa1); PK4(p1, 0, pa2); PK4(p1, 8, pa3);
#undef PK4
}
template <bool MLA>
__device__ __forceinline__ void qkt(f32x16& p0, f32x16& p1, const char* Ks, const char* Kr, const bf16x8* qr, const bf16x8* q2r, int r32, int hi, const f32x16& cinit) {
    p0 = cinit; p1 = cinit;
#pragma unroll
    for (int d0 = 0; d0 < 8; ++d0) { const int cb = (d0 * 16 + hi * 8) * 2;
        const bf16x8 b0 = *reinterpret_cast<const bf16x8*>(Ks + KSWZ(r32, cb));
        const bf16x8 b1 = *reinterpret_cast<const bf16x8*>(Ks + KSWZ(32 + r32, cb));
        p0 = __builtin_amdgcn_mfma_f32_32x32x16_bf16(b0, qr[d0], p0, 0, 0, 0);
        p1 = __builtin_amdgcn_mfma_f32_32x32x16_bf16(b1, qr[d0], p1, 0, 0, 0); }
    if constexpr (MLA) {
#pragma unroll
        for (int d0 = 0; d0 < 4; ++d0) { const int cb = (d0 * 16 + hi * 8) * 2;
            const bf16x8 b0 = *reinterpret_cast<const bf16x8*>(Kr + KRSWZ(r32, cb));
            const bf16x8 b1 = *reinterpret_cast<const bf16x8*>(Kr + KRSWZ(32 + r32, cb));
            const bf16x8 q2 = q2r[d0];
            p0 = __builtin_amdgcn_mfma_f32_32x32x16_bf16(b0, q2, p0, 0, 0, 0);
            p1 = __builtin_amdgcn_mfma_f32_32x32x16_bf16(b1, q2, p1, 0, 0, 0); }
    }
}
template <int OFF> __device__ __forceinline__ bf16x8 lds_rd(int a) { bf16x8 r; asm volatile("ds_read_b128 %0, %1 offset:%2" : "=v"(r) : "v"(a), "i"(OFF)); return r; }
template <int N> __device__ __forceinline__ void lds_wait(bf16x8& a, bf16x8& b) { asm volatile("s_waitcnt lgkmcnt(%2)" : "+v"(a), "+v"(b) : "i"(N)); }
template <bool MLA, bool FIXED>
__device__ __forceinline__ void qkt_fin(f32x16& y0, f32x16& y1, const char* Ks, const char* Kr, const bf16x8* qr, const bf16x8* q2r, int r32, int hi, const f32x16& cinit,
                                        f32x16& x0, f32x16& x1, float alpha, float& l_reg, bf16x8& pa0, bf16x8& pa1, bf16x8& pa2, bf16x8& pa3) {
    constexpr int NS = MLA ? 12 : 8;
    const int kx = (hi * 16) ^ ((r32 & 15) << 4), kbase = (int)(uintptr_t)Ks + r32 * 256;
    const int rx = (hi * 16) ^ (((r32 >> 1) & 7) << 4), rbase = (int)(uintptr_t)Kr + r32 * 128;
    bf16x8 ka[2], kb[2];
    y0 = cinit; y1 = cinit;
    float psa = 0.f, psb = 0.f; unsigned c0, c1, c2, c3;
#define QK_RD(s) do { if constexpr ((s) < 8) { const int a_ = kbase + (kx ^ ((s) * 32)); ka[(s) % 2] = lds_rd<0>(a_); kb[(s) % 2] = lds_rd<8192>(a_); }       \
        else if constexpr ((s) < NS) { const int a_ = rbase + (rx ^ (((s) - 8) * 32)); ka[(s) % 2] = lds_rd<0>(a_); kb[(s) % 2] = lds_rd<4096>(a_); } } while (0)
#define QK_RC(s) ((s) < NS ? 2 : 0)
#define FS_PK(X, B, OUT) do { u32x4 w_ = {c0, c1, c2, c3}; OUT = *reinterpret_cast<bf16x8*>(&w_); } while (0)
#define FS_SLOT(i) do { if constexpr ((i) < 16) { x1[(i)] = __builtin_amdgcn_exp2f(x1[(i)]); psa += x0[(i)]; if constexpr ((i) > 0) psb += x1[(i) - 1];                       \
        if constexpr ((i) < 8) { if constexpr (((i) & 3) == 0) c0 = cvt_pk2(x0[2 * (i)], x0[2 * (i) + 1]); else if constexpr (((i) & 3) == 1) c1 = cvt_pk2(x0[2 * (i)], x0[2 * (i) + 1]);           \
                                 else if constexpr (((i) & 3) == 2) c2 = cvt_pk2(x0[2 * (i)], x0[2 * (i) + 1]); else c3 = cvt_pk2(x0[2 * (i)], x0[2 * (i) + 1]);                                    \
                                 if constexpr ((i) == 3) FS_PK(x0, 0, pa0); if constexpr ((i) == 7) FS_PK(x0, 8, pa1); }                                                                           \
        else { constexpr int k_ = 2 * ((i) - 8);                                                                                                                                                 \
               if constexpr (((i) & 3) == 0) c0 = cvt_pk2(x1[k_], x1[k_ + 1]); else if constexpr (((i) & 3) == 1) c1 = cvt_pk2(x1[k_], x1[k_ + 1]);                                            \
               else if constexpr (((i) & 3) == 2) c2 = cvt_pk2(x1[k_], x1[k_ + 1]); else c3 = cvt_pk2(x1[k_], x1[k_ + 1]);                                                                    \
               if constexpr ((i) == 11) FS_PK(x1, 0, pa2); if constexpr ((i) == 15) FS_PK(x1, 8, pa3); } } } while (0)
#define QK_STEP(s) do { QK_RD((s) + 1); lds_wait<QK_RC((s) + 1)>(ka[(s) % 2], kb[(s) % 2]);                                                   \
        y0 = __builtin_amdgcn_mfma_f32_32x32x16_bf16(ka[(s) % 2], (s) < 8 ? qr[(s) < 8 ? (s) : 0] : q2r[(s) < 8 ? 0 : (MLA ? (s) - 8 : 0)], y0, 0, 0, 0); FS_SLOT(2 * (s)); SBAR();          \
        y1 = __builtin_amdgcn_mfma_f32_32x32x16_bf16(kb[(s) % 2], (s) < 8 ? qr[(s) < 8 ? (s) : 0] : q2r[(s) < 8 ? 0 : (MLA ? (s) - 8 : 0)], y1, 0, 0, 0); FS_SLOT(2 * (s) + 1); SBAR(); } while (0)
    QK_RD(0);
    QK_STEP(0); QK_STEP(1); QK_STEP(2); QK_STEP(3); QK_STEP(4); QK_STEP(5); QK_STEP(6); QK_STEP(7);
    if constexpr (MLA) { QK_STEP(8); QK_STEP(9); QK_STEP(10); QK_STEP(11); }
    psb += x1[15];
    float ps = psa + psb;
    { auto rr = __builtin_amdgcn_permlane32_swap(__float_as_uint(ps), __float_as_uint(ps), false, false); ps = __uint_as_float(rr[0]) + __uint_as_float(rr[1]); }
    l_reg = FIXED ? l_reg + ps : l_reg * alpha + ps;
#undef QK_RD
#undef QK_RC
#undef FS_PK
#undef FS_SLOT
#undef QK_STEP
}
__device__ __forceinline__ int v_st(int k, int c) { const int kk = (k & ~0xC) | ((k & 4) << 1) | ((k & 8) >> 1); return ((kk >> 3) * 4 + (c >> 5)) * 512 + ((kk & 7) * 32 + (c & 31)) * 2; }
__device__ __forceinline__ int v_rd_base(int lane) { return ((lane & 3) << 3) | (((lane >> 2) & 3) << 6) | (((lane >> 4) & 1) << 5) | (((lane >> 5) & 1) << 8); }
constexpr int v_rd_off(int d0, int ks, int half) { return d0 * 512 + ks * 4096 + half * 2048; }
template <int OFF> __device__ __forceinline__ s16x4 tr_read(int vb) {
    s16x4 r; asm volatile("ds_read_b64_tr_b16 %0, %1 offset:%2" : "=&v"(r) : "v"(vb), "i"(OFF) : "memory"); return r;
}
template <int D0> __device__ __forceinline__ void pv_one(f32x16& od, int vb, bf16x8 pa0, bf16x8 pa1, bf16x8 pa2, bf16x8 pa3) {
    const s16x4 l0 = tr_read<v_rd_off(D0, 0, 0)>(vb), h0 = tr_read<v_rd_off(D0, 0, 1)>(vb), l1 = tr_read<v_rd_off(D0, 1, 0)>(vb), h1 = tr_read<v_rd_off(D0, 1, 1)>(vb);
    const s16x4 l2 = tr_read<v_rd_off(D0, 2, 0)>(vb), h2 = tr_read<v_rd_off(D0, 2, 1)>(vb), l3 = tr_read<v_rd_off(D0, 3, 0)>(vb), h3 = tr_read<v_rd_off(D0, 3, 1)>(vb);
    asm volatile("s_waitcnt lgkmcnt(0)" ::: "memory"); SBAR();
#define PK(L, H) (bf16x8){L[0], L[1], L[2], L[3], H[0], H[1], H[2], H[3]}
    od = __builtin_amdgcn_mfma_f32_32x32x16_bf16(pa0, PK(l0, h0), od, 0, 0, 0);
    od = __builtin_amdgcn_mfma_f32_32x32x16_bf16(pa1, PK(l1, h1), od, 0, 0, 0);
    od = __builtin_amdgcn_mfma_f32_32x32x16_bf16(pa2, PK(l2, h2), od, 0, 0, 0);
    od = __builtin_amdgcn_mfma_f32_32x32x16_bf16(pa3, PK(l3, h3), od, 0, 0, 0);
#undef PK
}
__device__ __forceinline__ void pv_d0(f32x16* o, int vb, bf16x8 pa0, bf16x8 pa1, bf16x8 pa2, bf16x8 pa3) {
    pv_one<0>(o[0], vb, pa0, pa1, pa2, pa3); pv_one<1>(o[1], vb, pa0, pa1, pa2, pa3); pv_one<2>(o[2], vb, pa0, pa1, pa2, pa3); pv_one<3>(o[3], vb, pa0, pa1, pa2, pa3);
}

struct Item {
    const bf16_t* q;
    const bf16_t* q2;
    const bf16_t* k;
    const bf16_t* v;
    const bf16_t* k2;
    const bf16_t* gs;
    bf16_t* y;
    const float* qgain;
    const float* kgain;
    const f32x2* rope;
    const f32x2* rope0;
    int s0;
    int nkeys;
};

template <bool MLA>
__device__ __forceinline__ void attn_item(const Item& it, char* lds) {
    constexpr int LDK = Cfg<MLA>::LDK;
    constexpr int SD = MLA ? 1 : 2;
    const int tid = opaque_tid(), wid = tid >> 6, lane = tid & 63, r32 = lane & 31, hi = lane >> 5;
    char* V_lds = lds + OFF_V; char* K_lds = lds + OFF_K; char* KR_lds = lds + OFF_KR;
    float* ws = (float*)(lds + OFF_WS) + wid * 64; float* li_l = ws; float* al_l = ws + 32;
    float m_reg = 0.f, l_reg = 0; f32x16 o[4] = {}; bf16x8 qr[8];
    const char* qrl = lds + OFF_QR + wid * 4096 + lane * 16;
    bf16x8 q2v[MLA ? 4 : 1]; const bf16x8* q2r = q2v;
    const bf16_t* Kh = it.k; const bf16_t* Vh = it.v; const bf16_t* K2 = it.k2;
    const int vb0 = (int)(uintptr_t)V_lds + v_rd_base(lane);
    const int wv = __builtin_amdgcn_readfirstlane(wid);
    const int krow = 4 * wv + (lane >> 4);
    const unsigned gK = (unsigned)(krow * LDK + ((lane & 15) ^ (krow & 15)) * 8) * 2u;
    const int vblk = 2 * wv + (lane >> 5), vkk = (vblk >> 2) * 8 + ((lane >> 2) & 7), vk = vkk;
    const unsigned gV = (unsigned)(vk * LDK + (vblk & 3) * 32 + (lane & 3) * 8) * 2u;
    const int rrow = 8 * wv + (lane >> 3);
    const unsigned gR = (unsigned)(rrow * 64 + ((lane & 7) ^ ((rrow >> 1) & 7)) * 8) * 2u;
    LAS unsigned char* ldsl = (LAS unsigned char*)(uintptr_t)(unsigned)(uintptr_t)lds + wv * 1024;
    const __amdgpu_buffer_rsrc_t rK = __builtin_amdgcn_make_buffer_rsrc((void*)Kh, 0, 0x7fffffff, 0x00020000), rV = __builtin_amdgcn_make_buffer_rsrc((void*)Vh, 0, 0x7fffffff, 0x00020000);
    const __amdgpu_buffer_rsrc_t rR = __builtin_amdgcn_make_buffer_rsrc((void*)(MLA ? K2 : Kh), 0, 0x7fffffff, 0x00020000);
#define GLDS(rs, lp, vo, so) __builtin_amdgcn_raw_ptr_buffer_load_lds(rs, (LAS unsigned*)(lp), 16, (int)(vo), (int)(so), 0, 0)
#define DMA(b, k0) do { const unsigned so_ = (unsigned)(k0) * (unsigned)(LDK * 2);                                                                               \
    GLDS(rK, ldsl + OFF_K + (b) * (int)SHM_K, gK, so_); GLDS(rK, ldsl + OFF_K + (b) * (int)SHM_K + 8192, gK, so_ + 32u * LDK * 2u);                            \
    GLDS(rV, ldsl + OFF_V + (b) * (int)SHM_V, gV, so_); GLDS(rV, ldsl + OFF_V + (b) * (int)SHM_V + 8192, gV, so_ + 32u * LDK * 2u);                            \
    if constexpr (MLA) GLDS(rR, ldsl + OFF_KR + (b) * (int)SHM_KR, gR, (unsigned)(k0) * 128u); } while (0)
    __syncthreads();
    DMA(0, 0); DMA(1, KVBLK);
    float qsq = 0.f;
    {
        const bf16_t* Qw = it.q + (size_t)wid * (8 * 16 * 32 * 8) + hi * 256 + r32 * 8;
#pragma unroll
        for (int d0 = 0; d0 < 8; ++d0) qr[d0] = *reinterpret_cast<const bf16x8*>(Qw + d0 * 512);
        if constexpr (MLA) {
            const bf16_t* Qw2 = it.q2 + (size_t)wid * (8 * 8 * 32 * 8) + hi * 256 + r32 * 8;
#pragma unroll
            for (int d0 = 0; d0 < 4; ++d0) { const bf16x8 t_ = *reinterpret_cast<const bf16x8*>(Qw2 + d0 * 512); q2v[d0] = t_;
#pragma unroll
                for (int e = 0; e < 8; ++e) { const float f_ = bf2f((unsigned short)t_[e]); qsq = fmaf(f_, f_, qsq); } }
        }
    }
    if constexpr (!MLA) {
        const float* gp = it.qgain + hi * 8;
        const bool norope = it.rope == nullptr;
        const f32x4* rp = (const f32x4*)it.rope0 + (size_t)hi * SEQ + (norope ? 0 : it.s0) + wid * QBLK + r32;
        f32x4 G1[4][2], G2[4][2], R[4][4];
#pragma unroll
        for (int d0 = 0; d0 < 4; ++d0) {
            G1[d0][0] = *(const f32x4*)(gp + d0 * 16); G1[d0][1] = *(const f32x4*)(gp + d0 * 16 + 4); G2[d0][0] = *(const f32x4*)(gp + 64 + d0 * 16); G2[d0][1] = *(const f32x4*)(gp + 64 + d0 * 16 + 4);
#pragma unroll
            for (int q4 = 0; q4 < 4; ++q4) R[d0][q4] = rp[(size_t)(d0 * 4 + q4) * 2 * SEQ]; }
        float sq = 0.f;
#pragma unroll
        for (int d0 = 0; d0 < 8; ++d0)
#pragma unroll
            for (int e = 0; e < 8; ++e) { const float f_ = bf2f((unsigned short)qr[d0][e]); sq = fmaf(f_, f_, sq); }
        { auto rr = __builtin_amdgcn_permlane32_swap(__float_as_uint(sq), __float_as_uint(sq), false, false); sq = __uint_as_float(rr[0]) + __uint_as_float(rr[1]); }
        const float qrs = rsqrtf(sq * (1.0f / 128.0f) + EPS) * (0.08838834764831845f * 1.4426950408889634f);
#pragma unroll
        for (int d0 = 0; d0 < 4; ++d0) {
            float x1[8], x2[8];
#pragma unroll
            for (int j = 0; j < 8; ++j) { x1[j] = bf2f((unsigned short)qr[d0][j]) * qrs * G1[d0][j >> 2][j & 3]; x2[j] = bf2f((unsigned short)qr[d0 + 4][j]) * qrs * G2[d0][j >> 2][j & 3]; }
#pragma unroll
            for (int j = 0; j < 8; ++j) { const float tc = norope ? 1.f : R[d0][j >> 1][(j & 1) * 2], ts = norope ? 0.f : R[d0][j >> 1][(j & 1) * 2 + 1];
                const float a = x1[j], b = x2[j]; x1[j] = a * tc - b * ts; x2[j] = b * tc + a * ts; }
            u32x4 o1, o2;
#pragma unroll
            for (int j = 0; j < 4; ++j) { o1[j] = cvt_pk_bf16(x1[2 * j], x1[2 * j + 1]); o2[j] = cvt_pk_bf16(x2[2 * j], x2[2 * j + 1]); }
            qr[d0] = *reinterpret_cast<bf16x8*>(&o1); qr[d0 + 4] = *reinterpret_cast<bf16x8*>(&o2);
        }
    }
#define RESC(a) do { } while (0)
#define NXT(b) ((b) == NST - 1 ? 0 : (b) + 1)
    f32x16 pA0, pA1, pB0, pB1; float mnA, mnB, alA = 1.f, alB = 1.f; bf16x8 pa0, pa1, pa2, pa3; const int NT = it.nkeys / KVBLK;
    float pinit = 0.f;
    if constexpr (!MLA) {
        float mq = fmaxf(fabsf(it.qgain[lane]), fabsf(it.qgain[lane + 64])), mk = fmaxf(fabsf(it.kgain[lane]), fabsf(it.kgain[lane + 64]));
#pragma unroll
        for (int o = 1; o < 64; o <<= 1) { mq = fmaxf(mq, __shfl_xor(mq, o)); mk = fmaxf(mk, __shfl_xor(mk, o)); }
        pinit = fmaxf(-(11.313708498984761f * 1.4426950408889634f * 1.0001f) * mq * mk, -60.f);
    }
    if constexpr (MLA) {
#pragma unroll
        for (int d0 = 0; d0 < 8; ++d0)
#pragma unroll
            for (int e = 0; e < 8; ++e) { const float f_ = bf2f((unsigned short)qr[d0][e]); qsq = fmaf(f_, f_, qsq); }
        { auto rr = __builtin_amdgcn_permlane32_swap(__float_as_uint(qsq), __float_as_uint(qsq), false, false); qsq = __uint_as_float(rr[0]) + __uint_as_float(rr[1]); }
        float kr2 = fmaxf(fmaxf(it.kgain[lane], it.kgain[lane + 64]), fmaxf(it.kgain[lane + 128], it.kgain[lane + 192]));
#pragma unroll
        for (int o = 1; o < 64; o <<= 1) kr2 = fmaxf(kr2, __shfl_xor(kr2, o));
        const int j_ = lane & 15, g_ = lane >> 4;
        float kn2 = j_ < 9 ? fmaxf(it.qgain[(g_ * 2) * 16 + j_], it.qgain[(g_ * 2 + 1) * 16 + j_]) : 0.f;
        kn2 = fmaxf(kn2, __shfl_xor(kn2, 1)); kn2 = fmaxf(kn2, __shfl_xor(kn2, 2)); kn2 = fmaxf(kn2, __shfl_xor(kn2, 4)); kn2 = fmaxf(kn2, __shfl_xor(kn2, 8));
        kn2 += __shfl_xor(kn2, 16); kn2 += __shfl_xor(kn2, 32);
        const float k2 = kn2 + fmaxf(kr2, 0.f);
        pinit = fmaxf(-1.01f * __builtin_sqrtf(qsq * k2), -60.f);
    }
    f32x16 cinit;
#pragma unroll
    for (int r = 0; r < 16; ++r) cinit[r] = pinit;
    asm volatile("" : "+v"(cinit));
#define PSM(p0, p1, mn, al) partialSM_fixed(p0, pinit)
#define PSM1(p0, p1, mn, al) partialSM_fixed(p0, pinit)
    asm volatile("s_waitcnt vmcnt(0)" ::: "memory"); __syncthreads();
    qkt<MLA>(pA0, pA1, K_lds, KR_lds, qr, q2r, r32, hi, cinit); PSM1(pA0, pA1, mnA, alA);
#define WGBAR() do { asm volatile("s_waitcnt vmcnt(0) lgkmcnt(0)" ::: "memory"); __builtin_amdgcn_s_barrier(); asm volatile("" ::: "memory"); } while (0)
    int b0 = 0;
    for (int j = 0; j + 2 < NT; j += 2) {
        const int b1 = NXT(b0), b2 = NXT(b1);
        if constexpr (!MLA) qkt_fin<MLA, !MLA>(pB0, pB1, K_lds + b1 * (int)SHM_K, KR_lds + b1 * (int)SHM_KR, qr, q2r, r32, hi, cinit, pA0, pA1, alA, l_reg, pa0, pa1, pa2, pa3);
        else { qkt<MLA>(pB0, pB1, K_lds + b1 * (int)SHM_K, KR_lds + b1 * (int)SHM_KR, qr, q2r, r32, hi, cinit); finishSM<true>(pA0, pA1, alA, pinit, l_reg, pa0, pa1, pa2, pa3); } SBAR();
        DMA(b2, (j + 2) * KVBLK); SBAR();
        pv_d0(o, vb0 + b0 * (int)SHM_V, pa0, pa1, pa2, pa3);
        PSM(pB0, pB1, mnB, alB); RESC(alB);
        WGBAR();
        if constexpr (!MLA) qkt_fin<MLA, !MLA>(pA0, pA1, K_lds + b2 * (int)SHM_K, KR_lds + b2 * (int)SHM_KR, qr, q2r, r32, hi, cinit, pB0, pB1, alB, l_reg, pa0, pa1, pa2, pa3);
        else { qkt<MLA>(pA0, pA1, K_lds + b2 * (int)SHM_K, KR_lds + b2 * (int)SHM_KR, qr, q2r, r32, hi, cinit); finishSM<true>(pB0, pB1, alB, pinit, l_reg, pa0, pa1, pa2, pa3); } SBAR();
        DMA(b0, (j + 3) * KVBLK); SBAR();
        pv_d0(o, vb0 + b1 * (int)SHM_V, pa0, pa1, pa2, pa3);
        PSM(pA0, pA1, mnA, alA); RESC(alA);
        WGBAR();
        b0 = b2;
    }
    {
        const int b1 = NXT(b0);
        SBAR(); qkt<MLA>(pB0, pB1, K_lds + b1 * (int)SHM_K, KR_lds + b1 * (int)SHM_KR, qr, q2r, r32, hi, cinit);
        finishSM<true>(pA0, pA1, alA, pinit, l_reg, pa0, pa1, pa2, pa3); SBAR();
        pv_d0(o, vb0 + b0 * (int)SHM_V, pa0, pa1, pa2, pa3); PSM(pB0, pB1, mnB, alB);
        RESC(alB);
        finishSM<true>(pB0, pB1, alB, pinit, l_reg, pa0, pa1, pa2, pa3); SBAR();
        pv_d0(o, vb0 + b1 * (int)SHM_V, pa0, pa1, pa2, pa3);
    }
    __syncthreads();
    if (hi == 0) li_l[r32] = l_reg; asm volatile("s_waitcnt lgkmcnt(0)" ::: "memory");
    {
        char* ost = lds + OFF_OST + wid * (QBLK * OST_LD);
        const int err = lane >> 4, ech = lane & 15;
        const bf16_t* Gw = it.gs + (size_t)(wid * QBLK + err) * DM + ech * 8; bf16_t* Yw = it.y + (size_t)(wid * QBLK + err) * DM + ech * 8;
        u32x4 gv[4];
#pragma unroll
        for (int c = 0; c < 4; ++c) gv[c] = *(const u32x4*)(Gw + (size_t)c * 4 * DM);
        const bool odd = lane & 1;
#pragma unroll
        for (int r = 0; r < 16; ++r) { const int orow = crow(r, hi); const float rl = __builtin_amdgcn_rcpf(li_l[orow]);
#pragma unroll
            for (int d0 = 0; d0 < 4; ++d0) { const float val = o[d0][r] * rl;
                const float nb = __int_as_float(__builtin_amdgcn_mov_dpp(__float_as_int(val), 0xB1, 0xF, 0xF, true));
                const unsigned pk = cvt_pk_bf16(val, nb);
                if (!odd) *(unsigned*)(ost + orow * OST_LD + (d0 * 32 + r32) * 2) = pk; } }
        asm volatile("s_waitcnt lgkmcnt(0)" ::: "memory");
        const char* orp = ost + err * OST_LD + ech * 16;
#pragma unroll
        for (int c = 0; c < 4; ++c) { const u32x4 ov = *(const u32x4*)(orp + c * 4 * OST_LD); u32x4 yv;
#pragma unroll
            for (int j = 0; j < 4; ++j) yv[j] = cvt_pk_bf16(bflo(ov[j]) * bflo(gv[c][j]), bfhi(ov[j]) * bfhi(gv[c][j]));
            *(u32x4*)(Yw + (size_t)c * 4 * DM) = yv; gv[c] = *(const u32x4*)(Gw + (size_t)(c + 4) * 4 * DM); }
#pragma unroll
        for (int c = 4; c < 8; ++c) { const u32x4 ov = *(const u32x4*)(orp + c * 4 * OST_LD); u32x4 yv;
#pragma unroll
            for (int j = 0; j < 4; ++j) yv[j] = cvt_pk_bf16(bflo(ov[j]) * bflo(gv[c - 4][j]), bfhi(ov[j]) * bfhi(gv[c - 4][j]));
            *(u32x4*)(Yw + (size_t)c * 4 * DM) = yv; }
    }
#undef PSM
#undef PSM1
#undef DMA
#undef GLDS
#undef NXT
#undef WGBAR
#undef RESC
}
}
static_assert(attn::ATTN_LDS <= (size_t)LDSCTL_OFF, "attention LDS");

struct Frame {
    LAS unsigned char* lds; char* ldsg;
    int tid, lane, wave, G, bid;
    unsigned char* ws;
    __device__ __forceinline__ void refresh(KP P) { tid = opaque_tid(); lane = tid & 63; wave = __builtin_amdgcn_readfirstlane(tid >> 6); ws = P->ws; }
};

__device__ __forceinline__ void p_mod(Frame& F, int l, int worker, int nworkers) {
    const KP P = kparams(); F.refresh(P);
    float* sc = (float*)F.ldsg; float* red = (float*)(F.ldsg + 40960);
    float* MOD = (float*)(F.ws + WS_MOD);
    __syncthreads();
    for (int i = F.tid; i < 5 * DM; i += NTHREADS) { const int r = i >> 11, k = i & 2047; const float v = r < 4 ? P->c[r * DM + k] : P->c_ctx[k]; sc[i] = v / (1.0f + __expf(-v)); }
    __syncthreads();
    const int krow = F.lane >> 3, c4 = (F.lane & 7) * 4;
    for (int cgp = worker; cgp < 192; cgp += nworkers) {
        const float* W = P->w_ada + (size_t)l * DM * NMOD + cgp * 32 + c4;
        float acc[5][4];
#pragma unroll
        for (int r = 0; r < 5; ++r)
#pragma unroll
            for (int j = 0; j < 4; ++j) acc[r][j] = 0.f;
#pragma unroll 8
        for (int i = 0; i < 32; ++i) { const int k = F.wave * 256 + i * 8 + krow; const f32x4 w = __builtin_nontemporal_load((const f32x4*)(W + (size_t)k * NMOD));
#pragma unroll
            for (int r = 0; r < 5; ++r) { const float s = sc[r * DM + k];
#pragma unroll
                for (int j = 0; j < 4; ++j) acc[r][j] = fmaf(s, w[j], acc[r][j]); } }
#pragma unroll
        for (int r = 0; r < 5; ++r)
#pragma unroll
            for (int j = 0; j < 4; ++j) { float v = acc[r][j]; v += __shfl_xor(v, 8); v += __shfl_xor(v, 16); v += __shfl_xor(v, 32);
                if (F.lane < 8) red[(F.wave * 5 + r) * 32 + c4 + j] = v; }
        __syncthreads();
        if (F.tid < 160) { const int r = F.tid >> 5, cc = F.tid & 31; float s = 0.f;
#pragma unroll
            for (int w = 0; w < 8; ++w) s += red[(w * 5 + r) * 32 + cc];
            MOD[(size_t)(l * 5 + r) * NMOD + cgp * 32 + cc] = s + P->b_ada[l * NMOD + cgp * 32 + cc]; }
        __syncthreads();
    }
}
__device__ __forceinline__ void transpose_item(const float* W, int K, int N, bf16_t* WT, int k0, int n0, int drow0, int dsplit, const float* gain, float* scr, int lane) {
    const int lr = lane >> 4, lc = (lane & 15) * 4;
    f32x4 v[16];
#pragma unroll
    for (int i = 0; i < 16; ++i) v[i] = __builtin_nontemporal_load((const f32x4*)(W + (size_t)(k0 + 4 * i + lr) * N + n0 + lc));
#pragma unroll
    for (int i = 0; i < 16; ++i) { const int kk = 4 * i + lr; const float g = gain ? gain[k0 + kk] : 1.0f; float* s = scr + kk * 65 + lc;
        s[0] = v[i][0] * g; s[1] = v[i][1] * g; s[2] = v[i][2] * g; s[3] = v[i][3] * g; }
    LDS_WAIT(); asm volatile("" ::: "memory");
    const int c = lane & 7;
#pragma unroll
    for (int j = 0; j < 8; ++j) { const int n = (lane >> 3) + 8 * j; const float* s = scr + (8 * c) * 65 + n;
        u32x4 o; o.x = cvt_pk_bf16(s[0 * 65], s[1 * 65]); o.y = cvt_pk_bf16(s[2 * 65], s[3 * 65]); o.z = cvt_pk_bf16(s[4 * 65], s[5 * 65]); o.w = cvt_pk_bf16(s[6 * 65], s[7 * 65]);
        const int dr = (n < 32 || dsplit == 0) ? drow0 + n : drow0 + dsplit + (n - 32);
        *(u32x4*)(WT + (size_t)dr * K + k0 + 8 * c) = o; }
    LDS_WAIT(); asm volatile("" ::: "memory");
}
__device__ __forceinline__ void p_weights(Frame& F, int l, int worker, int nworkers, int part) {
    const KP P = kparams(); F.refresh(P);
    float* scr = (float*)(F.ldsg) + F.wave * (64 * 65);
    const int gw = worker * NWAVES + F.wave, NGW = nworkers * NWAVES;
    constexpr int I_IN = 32 * 73, I_UQ = 8 * 24, I_UKV = 8 * 32, I_OUT = 32 * 32, I_L = I_IN + I_UQ + I_UKV + I_OUT;
    const int it_lo = (part == 2 || part == 3) ? I_IN : part == 4 ? I_IN + I_UQ + I_UKV : 0, it_hi = part == 1 ? I_IN : part == 3 ? I_IN + I_UQ + I_UKV : I_L;
    for (int it = it_lo + gw; it < it_hi; it += NGW) {
        int r = it;
        if (r < I_IN) { const int kb = r / 73, nb = r % 73, n0 = nb * 64;
            const int d0 = n0 < 3584 ? n0 : (n0 < 3648 ? 4608 + (n0 - 3584) : n0 - 64);
            transpose_item(P->w_in + (size_t)l * DM * D_IN, DM, D_IN, (bf16_t*)(F.ws + WS_W1 + l * W1_L), kb * 64, n0, d0, 0, nullptr, scr, F.lane); continue; }
        r -= I_IN;
        if (r < I_UQ) { const int kb = r / 24, nb = r % 24, n0 = nb * 64, head = n0 / 192, e = n0 % 192;
            const int d0 = e < 128 ? head * 128 + e : 1024 + (head >> 2) * 256 + (head & 3) * 32;
            transpose_item(P->w_uq + (size_t)l * 512 * 1536, 512, 1536, (bf16_t*)(F.ws + WS_W2A + l * W2A_L), kb * 64, n0, d0, e < 128 ? 0 : 128, P->cq_gain + l * 512, scr, F.lane); continue; }
        r -= I_UQ;
        if (r < I_UKV) { const int kb = r / 32, nb = r % 32, n0 = nb * 64;
            transpose_item(P->w_ukv + (size_t)l * 512 * 2048, 512, 2048, (bf16_t*)(F.ws + WS_W2B + l * W2B_L), kb * 64, n0, n0, 0, P->ckv_gain + l * 512, scr, F.lane); continue; }
        r -= I_UKV;
        { const int kb = r / 32, nb = r % 32, n0 = nb * 64;
            transpose_item(P->w_out + (size_t)l * DM * DM, DM, DM, (bf16_t*)(F.ws + WS_W3 + l * W3_L), kb * 64, n0, n0, 0, nullptr, scr, F.lane); }
    }
    const int gt = worker * NTHREADS + F.tid, NGT = nworkers * NTHREADS;
    constexpr int PADV = 192 * DM * 2 / 16;
    if (part <= 1) { unsigned z; asm volatile("v_mov_b32 %0, 0" : "=v"(z));
        for (int i = gt; i < PADV; i += NGT) *(u32x4*)(F.ws + WS_W1 + l * W1_L + (size_t)D_IN * DM * 2 + (size_t)i * 16) = (u32x4){z, z, z, z}; }
}
__device__ __forceinline__ void p_rope(Frame& F) {
    const KP P = kparams(); F.refresh(P);
    const int gt = F.bid * NTHREADS + F.tid, NGT = F.G * NTHREADS;
    f32x2* RG = (f32x2*)(F.ws + WS_ROPEG); f32x2* RM = (f32x2*)(F.ws + WS_ROPEM);
    for (int i = gt; i < SEQ * 96; i += NGT) {
        const int s = i / 96, e = i % 96; const int row = s >> 6, col = s & 63;
        float ang; f32x2* dst;
        if (e < 64) { const int f = e & 31; const float inv = exp2f(-(float)f * (13.287712379549449f / 32.0f)); ang = (float)(e < 32 ? row : col) * inv; dst = RG + (size_t)s * 64 + e; }
        else { const int e2 = e - 64, f = e2 & 15; const float inv = exp2f(-(float)f * (13.287712379549449f / 16.0f)); ang = (float)(e2 < 16 ? row : col) * inv; dst = RM + (size_t)s * 32 + e2; }
        const float tr = ang * 0.15915494309189535f; const float fr = tr - floorf(tr);
        f32x2 o; o.x = __builtin_amdgcn_cosf(fr); o.y = __builtin_amdgcn_sinf(fr); *dst = o;
        if (e < 64) { const int d0 = e >> 4, hi_ = (e >> 3) & 1, j = e & 7;
            ((f32x2*)(F.ws + WS_XL))[((size_t)(((d0 * 4 + (j >> 1)) * 2 + hi_) * SEQ + s)) * 2 + (j & 1)] = o; }
    }
}

__device__ __forceinline__ void p_norm(Frame& F, int l, int rlo) {
    const KP P = kparams(); F.refresh(P);
    const int gw = F.bid * NWAVES + F.wave, NGW = F.G * NWAVES;
    const float* MOD = (const float*)(F.ws + WS_MOD) + (size_t)l * 5 * NMOD;
    const float* ng = P->norm_g + l * DM;
    bf16_t* H = (bf16_t*)(F.ws + WS_H);
    const float* xc = l <= 1 ? P->ctx : (const float*)(F.ws + WS_XC);
    const bf16_t* XH = (const bf16_t*)(F.ws + WS_XH); const unsigned char* XL = F.ws + WS_XL;
    const bf16_t* slab = (const bf16_t*)(F.ws + WS_SLAB); float* xcw = (float*)(F.ws + WS_XC);
    const float* gprev = MOD - 5 * NMOD + 4 * NMOD + 2 * DM;
    f32x4 na[4], nb[4];
    auto fetch0 = [&](int r) { const float* xr = r < NLAT ? P->x + (size_t)r * DM : P->ctx + (size_t)(r - NLAT) * DM;
#pragma unroll
        for (int j = 0; j < 4; ++j) { na[j] = *(const f32x4*)(xr + (F.lane + 64 * j) * 8); nb[j] = *(const f32x4*)(xr + (F.lane + 64 * j) * 8 + 4); } };
    if (l == 0 && rlo + gw < MROWS) fetch0(rlo + gw);
    for (int r = rlo + gw; r < MROWS; r += NGW) {
        const int b5 = r < NLAT ? (r >> 11) : 4;
        f32x4 va[4], vb[4]; float ss = 0.f;
        if (l == 0) {
#pragma unroll
            for (int j = 0; j < 4; ++j) { va[j] = na[j]; vb[j] = nb[j]; }
            if (r + NGW < MROWS) fetch0(r + NGW);
        } else if (r < NLAT && l > 0) {
#pragma unroll
            for (int j = 0; j < 4; ++j) { const size_t o = (size_t)r * DM + (F.lane + 64 * j) * 8; xdec8(*(const u32x4*)(XH + o), va[j], vb[j]); }
        } else {
            const float* xr = r < NLAT ? P->x + (size_t)r * DM : xc + (size_t)(r - NLAT) * DM;
#pragma unroll
            for (int j = 0; j < 4; ++j) { va[j] = *(const f32x4*)(xr + (F.lane + 64 * j) * 8); vb[j] = *(const f32x4*)(xr + (F.lane + 64 * j) * 8 + 4); }
        }
        if (l > 0 && r >= NLAT) {
#pragma unroll
            for (int j = 0; j < 4; ++j) { const int k = (F.lane + 64 * j) * 8; const size_t o = (size_t)(r - NLAT) * DM + k; const u32x4 w0 = *(const u32x4*)(slab + o); f32x4 sa = {bflo(w0.x), bfhi(w0.x), bflo(w0.y), bfhi(w0.y)}, sb = {bflo(w0.z), bfhi(w0.z), bflo(w0.w), bfhi(w0.w)};
#pragma unroll
                for (int ks = 1; ks < 8; ++ks) { const u32x4 w = *(const u32x4*)(slab + (size_t)ks * NCTX * DM + o);
                    sa[0] += bflo(w.x); sa[1] += bfhi(w.x); sa[2] += bflo(w.y); sa[3] += bfhi(w.y); sb[0] += bflo(w.z); sb[1] += bfhi(w.z); sb[2] += bflo(w.w); sb[3] += bfhi(w.w); }
                va[j] += *(const f32x4*)(gprev + k) * sa; vb[j] += *(const f32x4*)(gprev + k + 4) * sb; *(f32x4*)(xcw + o) = va[j]; *(f32x4*)(xcw + o + 4) = vb[j]; }
        }
#pragma unroll
        for (int j = 0; j < 4; ++j) ss += ((va[j][0] * va[j][0] + va[j][1] * va[j][1]) + (va[j][2] * va[j][2] + va[j][3] * va[j][3])) + ((vb[j][0] * vb[j][0] + vb[j][1] * vb[j][1]) + (vb[j][2] * vb[j][2] + vb[j][3] * vb[j][3]));
        const float rs = rsqrtf(wave_sum(ss) * (1.0f / DM) + EPS);
        const float* msh = MOD + b5 * NMOD; const float* msc = msh + DM;
#pragma unroll
        for (int j = 0; j < 4; ++j) { const int k = (F.lane + 64 * j) * 8;
            const f32x4 ga = *(const f32x4*)(ng + k) * (*(const f32x4*)(msc + k) + 1.0f), gb = *(const f32x4*)(ng + k + 4) * (*(const f32x4*)(msc + k + 4) + 1.0f);
            const f32x4 ha = va[j] * rs * ga + *(const f32x4*)(msh + k), hb = vb[j] * rs * gb + *(const f32x4*)(msh + k + 4);
            *(u32x4*)(H + (size_t)r * DM + k) = pack8(ha, hb); }
    }
}
__device__ __forceinline__ void p_norm_ctx(Frame& F, int l) {
    const KP P = kparams(); F.refresh(P);
    if (F.G * 4 != NCTX) { p_norm(F, l, NLAT); return; }
    const float* MOD = (const float*)(F.ws + WS_MOD) + (size_t)l * 5 * NMOD;
    const float* ng = P->norm_g + l * DM;
    bf16_t* H = (bf16_t*)(F.ws + WS_H);
    const float* xc = P->ctx; const bf16_t* xch = (const bf16_t*)(F.ws + WS_XC);
    const bf16_t* slab = (const bf16_t*)(F.ws + WS_SLAB); bf16_t* xcw = (bf16_t*)(F.ws + WS_XC);
    const float* gprev = MOD - 5 * NMOD + 4 * NMOD + 2 * DM;
    float* red = (float*)F.ldsg;
    const int rr = F.bid * 4 + (F.wave >> 1), kh = (F.wave & 1) * (DM / 2);
    f32x4 va[2], vb[2]; float ss = 0.f;
#pragma unroll
    for (int j = 0; j < 2; ++j) { const int k = kh + (F.lane + 64 * j) * 8; const size_t o = (size_t)rr * DM + k;
        if (l <= 1) { va[j] = *(const f32x4*)(xc + o); vb[j] = *(const f32x4*)(xc + o + 4); } else xdec8(*(const u32x4*)(xch + o), va[j], vb[j]);
        const u32x4 w0 = *(const u32x4*)(slab + o); f32x4 sa = {bflo(w0.x), bfhi(w0.x), bflo(w0.y), bfhi(w0.y)}, sb = {bflo(w0.z), bfhi(w0.z), bflo(w0.w), bfhi(w0.w)};
#pragma unroll
        for (int ks = 1; ks < 8; ++ks) { const u32x4 w = *(const u32x4*)(slab + (size_t)ks * NCTX * DM + o);
            sa[0] += bflo(w.x); sa[1] += bfhi(w.x); sa[2] += bflo(w.y); sa[3] += bfhi(w.y); sb[0] += bflo(w.z); sb[1] += bfhi(w.z); sb[2] += bflo(w.w); sb[3] += bfhi(w.w); }
        va[j] += *(const f32x4*)(gprev + k) * sa; vb[j] += *(const f32x4*)(gprev + k + 4) * sb; { u32x4 h_; xenc8(va[j], vb[j], h_); *(u32x4*)(xcw + o) = h_; }
        ss += ((va[j][0] * va[j][0] + va[j][1] * va[j][1]) + (va[j][2] * va[j][2] + va[j][3] * va[j][3])) + ((vb[j][0] * vb[j][0] + vb[j][1] * vb[j][1]) + (vb[j][2] * vb[j][2] + vb[j][3] * vb[j][3])); }
    ss = wave_sum(ss);
    __syncthreads();
    if (F.lane == 0) red[F.wave] = ss;
    __syncthreads();
    const float rs = rsqrtf((red[F.wave] + red[F.wave ^ 1]) * (1.0f / DM) + EPS);
    const float* msh = MOD + 4 * NMOD; const float* msc = msh + DM;
#pragma unroll
    for (int j = 0; j < 2; ++j) { const int k = kh + (F.lane + 64 * j) * 8;
        const f32x4 ga = *(const f32x4*)(ng + k) * (*(const f32x4*)(msc + k) + 1.0f), gb = *(const f32x4*)(ng + k + 4) * (*(const f32x4*)(msc + k + 4) + 1.0f);
        const f32x4 ha = va[j] * rs * ga + *(const f32x4*)(msh + k), hb = vb[j] * rs * gb + *(const f32x4*)(msh + k + 4);
        *(u32x4*)(H + (size_t)(NLAT + rr) * DM + k) = pack8(ha, hb); }
    __syncthreads();
}

__device__ __forceinline__ void p_final(Frame& F) {
    const KP P = kparams(); F.refresh(P);
    const int gw = F.bid * NWAVES + F.wave, NGW = F.G * NWAVES;
    const bf16_t* XH = (const bf16_t*)(F.ws + WS_XH); const unsigned char* XL = F.ws + WS_XL;
    for (int r = gw; r < NLAT; r += NGW) {
        f32x4 va[4], vb[4]; float ss = 0.f;
#pragma unroll
        for (int j = 0; j < 4; ++j) { const size_t o = (size_t)r * DM + (F.lane + 64 * j) * 8; xdec8(*(const u32x4*)(XH + o), va[j], vb[j]);
            ss += ((va[j][0] * va[j][0] + va[j][1] * va[j][1]) + (va[j][2] * va[j][2] + va[j][3] * va[j][3])) + ((vb[j][0] * vb[j][0] + vb[j][1] * vb[j][1]) + (vb[j][2] * vb[j][2] + vb[j][3] * vb[j][3])); }
        const float rs = rsqrtf(wave_sum(ss) * (1.0f / DM) + EPS);
        float* orow = P->out + (size_t)r * DM;
#pragma unroll
        for (int j = 0; j < 4; ++j) { const int k = (F.lane + 64 * j) * 8;
            *(f32x4*)(orow + k) = va[j] * rs * *(const f32x4*)(P->final_g + k); *(f32x4*)(orow + k + 4) = vb[j] * rs * *(const f32x4*)(P->final_g + k + 4); }
    }
}

__device__ __forceinline__ void p_kfin(Frame& F, int l) {
    const KP P = kparams(); F.refresh(P);
    const int gw = F.bid * NWAVES + F.wave, NGW = F.G * NWAVES;
    const bf16_t* KG = (const bf16_t*)(F.ws + WS_KG); const bf16_t* KR = (const bf16_t*)(F.ws + WS_KR);
    bf16_t* KGF = (bf16_t*)(F.ws + WS_KGF); bf16_t* KRF = (bf16_t*)(F.ws + WS_KRF);
    const f32x2* RG = (const f32x2*)(F.ws + WS_ROPEG); const f32x2* RM = (const f32x2*)(F.ws + WS_ROPEM);
    const int lane = F.lane, hl = lane & 31, d = hl * 4;
    const f32x4 kg = *(const f32x4*)(P->k_gain + l * 128 + d);
    const bf16_t* QG = (const bf16_t*)(F.ws + WS_QG); bf16_t* QGF = (bf16_t*)(F.ws + WS_QGF);
    const int qh = lane >> 3, s8 = lane & 7;
    const float* qgp = P->q_gain + l * 128 + s8 * 8;
    const f32x4 qg0 = *(const f32x4*)(qgp), qg1 = *(const f32x4*)(qgp + 4), qg2 = *(const f32x4*)(qgp + 64), qg3 = *(const f32x4*)(qgp + 68);
    float kb0 = 0.f, kb1 = 0.f, kb2 = 0.f, kb3 = 0.f;
    struct Raw { u32x2 wk, wr; f32x2 ck[4], cr[4]; };
    const int l16 = lane & 15;
    auto fetch = [&](int r, Raw& x) {
        const int s = r & 2047;
        x.wk = *(const u32x2*)(KG + (size_t)r * 256 + lane * 4);
        x.wr = *(const u32x2*)(KR + (size_t)r * 64 + l16 * 4);
        const f32x2* c2 = RG + (size_t)s * 64 + (hl & 15) * 4; const f32x2* c3 = RM + (size_t)s * 32 + (l16 & 7) * 4;
#pragma unroll
        for (int e = 0; e < 4; ++e) { x.ck[e] = c2[e]; x.cr[e] = c3[e]; }
    };
    Raw cur, nxt;
    if (gw < MROWS) fetch(gw, cur);
    for (int r = gw; r < MROWS; r += NGW) {
        const int kvr = kvrow_of(r); const bool lat = r < NLAT;
        if (r + NGW < MROWS) fetch(r + NGW, nxt);
        const u32x2 w = cur.wk;
        float x[4] = {bflo(w.x), bfhi(w.x), bflo(w.y), bfhi(w.y)};
        float ss = (x[0] * x[0] + x[1] * x[1]) + (x[2] * x[2] + x[3] * x[3]);
#pragma unroll
        for (int o = 1; o < 32; o <<= 1) ss += __shfl_xor(ss, o);
        const float rs = rsqrtf(ss * (1.0f / 128.0f) + EPS);
#pragma unroll
        for (int e = 0; e < 4; ++e) x[e] *= rs * kg[e];
        float px[4];
#pragma unroll
        for (int e = 0; e < 4; ++e) px[e] = __shfl_xor(x[e], 16);
        if (lat) {
#pragma unroll
            for (int e = 0; e < 4; ++e) { const f32x2 t = cur.ck[e]; x[e] = (hl < 16) ? (x[e] * t.x - px[e] * t.y) : (x[e] * t.x + px[e] * t.y); }
        }
        u32x2 ow; ow.x = cvt_pk_bf16(x[0], x[1]); ow.y = cvt_pk_bf16(x[2], x[3]);
        *(u32x2*)(KGF + (size_t)kvr * 256 + lane * 4) = ow;
        {
            const u32x2 w2 = cur.wr;
            float y[4] = {bflo(w2.x), bfhi(w2.x), bflo(w2.y), bfhi(w2.y)}; float py[4];
#pragma unroll
            for (int e = 0; e < 4; ++e) py[e] = __shfl_xor(y[e], 8);
            if (lat) {
#pragma unroll
                for (int e = 0; e < 4; ++e) { const f32x2 t = cur.cr[e]; y[e] = (l16 < 8) ? (y[e] * t.x - py[e] * t.y) : (y[e] * t.x + py[e] * t.y); } }
            if (lane < 16) { u32x2 o2; o2.x = cvt_pk_bf16(y[0], y[1]); o2.y = cvt_pk_bf16(y[2], y[3]); *(u32x2*)(KRF + (size_t)kvr * 64 + l16 * 4) = o2; }
            float ks = (y[0] * y[0] + y[1] * y[1]) + (y[2] * y[2] + y[3] * y[3]);
            ks += __shfl_xor(ks, 1); ks += __shfl_xor(ks, 2); ks += __shfl_xor(ks, 4); ks += __shfl_xor(ks, 8);
            { const int b_ = lat ? (r >> 11) : ((r - NLAT) >> 8); kb0 = b_ == 0 ? fmaxf(kb0, ks) : kb0; kb1 = b_ == 1 ? fmaxf(kb1, ks) : kb1; kb2 = b_ == 2 ? fmaxf(kb2, ks) : kb2; kb3 = b_ == 3 ? fmaxf(kb3, ks) : kb3; }
        }
        cur = nxt;
    }
    {
        float* red = (float*)F.ldsg;
        __syncthreads();
        if (lane == 0) { red[F.wave * 4 + 0] = kb0; red[F.wave * 4 + 1] = kb1; red[F.wave * 4 + 2] = kb2; red[F.wave * 4 + 3] = kb3; }
        __syncthreads();
        if (F.tid < 4) { float m = red[F.tid];
#pragma unroll
            for (int w = 1; w < NWAVES; ++w) m = fmaxf(m, red[w * 4 + F.tid]);
            ((float*)(F.ws + WS_CTL + CTL_KRMAX))[(l * 4 + F.tid) * 256 + (F.bid & 255)] = m; }
        __syncthreads();
    }
}

__device__ __forceinline__ void p_attn(Frame& F, int l) {
    const KP P = kparams(); F.refresh(P);
    const bf16_t* QG = (const bf16_t*)(F.ws + WS_QG); const bf16_t* KGF = (const bf16_t*)(F.ws + WS_KGF); const bf16_t* VG = (const bf16_t*)(F.ws + WS_VG);
    const bf16_t* QMN = (const bf16_t*)(F.ws + WS_QMN); const bf16_t* QMR = (const bf16_t*)(F.ws + WS_QMR);
    const bf16_t* KMN = (const bf16_t*)(F.ws + WS_KMN); const bf16_t* VM = (const bf16_t*)(F.ws + WS_VM); const bf16_t* KRF = (const bf16_t*)(F.ws + WS_KRF);
    const bf16_t* GS = (const bf16_t*)(F.ws + WS_GS); bf16_t* Y = (bf16_t*)(F.ws + WS_Y);
    const f32x2* RG = (const f32x2*)(F.ws + WS_ROPEG);
    const int nitems = (l < DEPTH - 1) ? 576 : 512;
    for (int i = F.bid; i < nitems; i += F.G) {
        attn::Item it; bool mla; int b, h, row0, nk; const f32x2* rope = nullptr;
        if (i < 256) { const int x = i & 7, j = i >> 3; b = x >> 1; h = (x & 1) * 4 + (j >> 3); const int qb = j & 7; mla = false; row0 = b * SEQ + qb * 256; nk = NKEY; rope = RG + (size_t)(qb * 256) * 64; }
        else if (i < 512) { const int ii = i - 256, x = ii & 7, j = ii >> 3, combo = x * 4 + (j >> 3); b = combo >> 3; h = combo & 7; const int qb = j & 7; mla = true; row0 = b * SEQ + qb * 256; nk = NKEY; }
        else if (i < 544) { const int ii = i - 512; b = ii >> 3; h = ii & 7; mla = false; row0 = NLAT + b * CTXL; nk = CTXL; }
        else { const int ii = i - 544; b = ii >> 3; h = ii & 7; mla = true; row0 = NLAT + b * CTXL; nk = CTXL; }
        it.nkeys = nk; it.rope = rope; it.rope0 = (const f32x2*)(F.ws + WS_XL); it.s0 = rope ? (int)((rope - RG) >> 6) : 0; it.qgain = P->q_gain + l * 128; it.kgain = P->k_gain + l * 128;
        if (!mla) {
            it.q = QG + qblk_off(row0, h, 0, 16); it.q2 = nullptr;
            it.k = KGF + (size_t)b * NKEY * 256 + (h >> 2) * 128; it.v = VG + (size_t)b * NKEY * 256 + (h >> 2) * 128; it.k2 = nullptr;
            it.gs = GS + (size_t)row0 * DM + h * 128; it.y = Y + (size_t)row0 * DM + h * 128;
            attn::attn_item<false>(it, F.ldsg);
        } else {
            it.qgain = (const float*)(F.ws + WS_CTL + CTL_KMAX) + ((l * 4 + b) * 8 + h) * (4 * 2 * 16); it.kgain = (const float*)(F.ws + WS_CTL + CTL_KRMAX) + (l * 4 + b) * 256;
            it.q = QMN + qblk_off(row0, h, 0, 16); it.q2 = QMR + qblk_off(row0, h, 0, 8);
            it.k = KMN + (size_t)b * NKEY * 1024 + h * 128; it.v = VM + (size_t)b * NKEY * 1024 + h * 128; it.k2 = KRF + (size_t)b * NKEY * 64;
            it.gs = GS + (size_t)row0 * DM + 1024 + h * 128; it.y = Y + (size_t)row0 * DM + 1024 + h * 128;
            attn::attn_item<true>(it, F.ldsg);
        }
    }
}

constexpr int N_PHASES = 2 + 5 * DEPTH;

__global__ void __launch_bounds__(NTHREADS, 2) fwd_kernel(Params Pv) {
    extern __shared__ __attribute__((aligned(16))) unsigned char lds[];
    Frame F;
    F.lds = (LAS unsigned char*)lds; F.ldsg = (char*)lds;
    F.G = gridDim.x; F.bid = blockIdx.x;
    { const KP P = kparams(); F.refresh(P); }
#if MK_ONE_LAUNCH
    cg::grid_group grid = cg::this_grid();
    volatile LAS unsigned* MISC = (volatile LAS unsigned*)(F.lds + MISC_OFF);
    for (int u = F.tid; u < (LDS_BYTES - LDSCTL_OFF) / 4; u += NTHREADS) ((LAS unsigned*)(F.lds + LDSCTL_OFF))[u] = 0u;
    __syncthreads();
    const XcdBarrier bar = xcd_barrier_post((unsigned*)(F.ws + WS_CTL) + CW_BAR, MISC + 8);
#define GRID_BAR() xcd_barrier(bar)
#define GRID_BAR0() xcd_barrier(bar)
    (void)grid;
#else
#define GRID_BAR() do {} while (0)
#define GRID_BAR0() do {} while (0)
#endif
    int lo, hi; { const KP P = kparams(); lo = P->ph_lo; hi = P->ph_hi; }
#define IN(k) (lo <= (k) && (k) < hi)
    if (IN(0)) { p_rope(F); p_weights(F, 0, F.bid, F.G, F.G > 64 ? 1 : 0); if (F.G > 64) p_weights(F, 0, F.bid, F.G, 3);
        if (F.G <= 64) { for (int l = 1; l < DEPTH; ++l) { p_weights(F, l, F.bid, F.G, 2); p_mod(F, l, F.bid, F.G); } }
        p_mod(F, 0, F.bid, F.G);
        GRID_BAR0(); }
    for (int l = 0; l < DEPTH; ++l) {
        const int pb = 1 + 5 * l;
        if (IN(pb) && l == 0) { p_norm(F, 0, 0); GRID_BAR(); }
        if (IN(pb + 1)) {
            const KP P = kparams(); F.refresh(P);
            pg8::Gemm g; g.A0 = g.A1 = (const bf16_t*)(F.ws + WS_H); g.B0 = g.B1 = (const bf16_t*)(F.ws + WS_W1 + l * W1_L); g.K = DM;
            pg8::StaticOrder S; S.init(MROWS / 256, N1 / 256, F.G, F.bid, DM / 64);
            Epi1 E{F.ws};
            pg8::gemm_phase<Epi1, pg8::StaticOrder, true, true>(F.lds, g, S, E);
            { constexpr int NU = (MROWS / 256) * (N1 / 256); const int full = NU % F.G;
              if (l + 1 < DEPTH && (full == 0 || F.bid >= full)) p_weights(F, l + 1, full ? F.bid - full : F.bid, full ? F.G - full : F.G, 1);
              if (l == 0 && F.G > 64 && (full == 0 || F.bid >= full)) p_weights(F, 0, full ? F.bid - full : F.bid, full ? F.G - full : F.G, 4); }
            GRID_BAR();
        }
        if (IN(pb + 2)) {
            p_kfin(F, l);
            const KP P = kparams(); F.refresh(P);
            pg8::Gemm g; g.A0 = (const bf16_t*)(F.ws + WS_CQ); g.A1 = (const bf16_t*)(F.ws + WS_CKV);
            g.B0 = (const bf16_t*)(F.ws + WS_W2A + l * W2A_L); g.B1 = (const bf16_t*)(F.ws + WS_W2B + l * W2B_L); g.K = 512;
            pg8::GroupOrder S{MROWS / 256, 6, 8, F.G, F.bid};
            Epi2 E{F.ws, l};
            pg8::gemm_phase<Epi2, pg8::GroupOrder, true, true>(F.lds, g, S, E);
            GRID_BAR();
        }
        if (IN(pb + 3)) { p_attn(F, l);
            if (l + 1 < DEPTH && F.G > 64 && F.bid >= 64) { __syncthreads(); p_weights(F, l + 1, F.bid - 64, F.G - 64, 2); p_mod(F, l + 1, F.bid - 64, F.G - 64); }
            GRID_BAR(); }
        if (IN(pb + 4)) {
            const KP P = kparams(); F.refresh(P);
            pg8::Gemm g; g.A0 = g.A1 = (const bf16_t*)(F.ws + WS_Y); g.B0 = g.B1 = (const bf16_t*)(F.ws + WS_W3 + l * W3_L); g.K = DM;
            pg8::G3Order S{F.G, F.bid, l < DEPTH - 1 ? 1 : 0};
            const bool lastl = l == DEPTH - 1;
            Epi3 E{F.ws, F.lds, l};
            pg8::gemm_phase<Epi3, pg8::G3Order, true, true>(F.lds, g, S, E);
            if (!lastl) { p_norm_ctx(F, l + 1); GRID_BAR(); }
        }
    }

#undef IN
}

extern "C" void kernel_launch(void* const* d_in, const int* in_sizes, int n_in, void* d_out, int out_size, void* d_ws, size_t ws_size, hipStream_t stream) {
    static int grid = 0;
    if (grid == 0) {
        if (n_in != 16 || out_size != NLAT * DM || ws_size < WS_END) { fprintf(stderr, "kernel_launch: unexpected shapes: n_in %d out %d ws %zu (need %zu)\n", n_in, out_size, ws_size, (size_t)WS_END); grid = -1; return; }
        int dev = 0, cus = 0, per_cu = 0;
        if (hipGetDevice(&dev) != hipSuccess || hipDeviceGetAttribute(&cus, hipDeviceAttributeMultiprocessorCount, dev) != hipSuccess) { grid = -1; return; }
        if (hipFuncSetAttribute((const void*)fwd_kernel, hipFuncAttributeMaxDynamicSharedMemorySize, LDS_BYTES) != hipSuccess) { fprintf(stderr, "kernel_launch: hipFuncSetAttribute failed\n"); grid = -1; return; }
        if (hipOccupancyMaxActiveBlocksPerMultiprocessor(&per_cu, (const void*)fwd_kernel, NTHREADS, LDS_BYTES) != hipSuccess || per_cu < 1) { fprintf(stderr, "kernel_launch: occupancy query says %d blocks per CU\n", per_cu); (void)hipGetLastError(); grid = -1; return; }
        grid = cus * 1;
    }
    if (grid < 0) return;
    Params p{};
    p.x = (const float*)d_in[0]; p.c = (const float*)d_in[1]; p.ctx = (const float*)d_in[2]; p.c_ctx = (const float*)d_in[3];
    p.w_ada = (const float*)d_in[4]; p.b_ada = (const float*)d_in[5]; p.norm_g = (const float*)d_in[6]; p.w_in = (const float*)d_in[7];
    p.q_gain = (const float*)d_in[8]; p.k_gain = (const float*)d_in[9]; p.cq_gain = (const float*)d_in[10]; p.ckv_gain = (const float*)d_in[11];
    p.w_uq = (const float*)d_in[12]; p.w_ukv = (const float*)d_in[13]; p.w_out = (const float*)d_in[14]; p.final_g = (const float*)d_in[15];
    p.out = (float*)d_out; p.ws = (unsigned char*)d_ws;
#if MK_ONE_LAUNCH
    if (hipMemsetAsync((char*)d_ws + WS_CTL, 0, 65536, stream) != hipSuccess) { fprintf(stderr, "kernel_launch: memset failed\n"); return; }
    p.ph_lo = 0; p.ph_hi = N_PHASES;
    void* args[] = {&p};
    hipError_t e = hipLaunchCooperativeKernel((const void*)fwd_kernel, dim3(grid), dim3(NTHREADS), args, LDS_BYTES, stream);
    if (e != hipSuccess) fprintf(stderr, "kernel_launch: cooperative launch failed: %s (grid %d)\n", hipGetErrorString(e), grid);
#else
    for (int ph = 0; ph < N_PHASES; ++ph) {
        p.ph_lo = ph; p.ph_hi = ph + 1;
        hipLaunchKernelGGL(fwd_kernel, dim3(grid), dim3(NTHREADS), LDS_BYTES, stream, p);
    }
    const hipError_t le = hipPeekAtLastError();
    if (le != hipSuccess) fprintf(stderr, "kernel_launch: launch failed: %s\n", hipGetErrorName(le));
#endif
}
```
